# Optimizing an MI355X kernel written in HIP

```python
import jax, jax.numpy as jnp
from jax import lax
import numpy as np

D_MODEL = 1024
BATCH = 32
SEQ = 2048
DEPTH = 1

D_MIX = D_MODEL
D_GMLP = D_MIX // 2
GMLP_GROUPS = 4
GMLP_GROUP_DIM = D_GMLP // GMLP_GROUPS
GMLP_CHUNK = 128
D_HGRN = D_MIX - D_GMLP
HGRN_HEADS = 4
HGRN_DK = D_HGRN // HGRN_HEADS
HGRN_DV = D_HGRN // HGRN_HEADS
HGRN_CHUNK = 64
D_IN_PROJ = 2 * D_GMLP + 4 * D_HGRN
N_MEM = 256
XATTN_HEADS = 4
XATTN_HEAD_DIM = D_MODEL // XATTN_HEADS
N_GROUPS = 4
EXPERTS_PER_GROUP = 8
N_EXPERTS = N_GROUPS * EXPERTS_PER_GROUP
TOP_K_IN_GROUP = 2
D_EXPERT = D_MODEL // 2
EXPERT_BLOCK = 256
EPS = 1e-6

kernel_name = "hybrid_gmlp_hgrn2_xattn_hmoe"


def rms_norm(x, gain):
    x32 = x.astype(jnp.float32)
    y = x32 * lax.rsqrt(jnp.mean(x32 * x32, axis=-1, keepdims=True) + EPS)
    return (y * gain.astype(jnp.float32)).astype(x.dtype)


def layer_norm(x, gain):
    x32 = x.astype(jnp.float32)
    mu = jnp.mean(x32, axis=-1, keepdims=True)
    xc = x32 - mu
    y = xc * lax.rsqrt(jnp.mean(xc * xc, axis=-1, keepdims=True) + EPS)
    return (y * gain.astype(jnp.float32)).astype(x.dtype)


def gmlp_heads(u, v, ln_gain, w_s, b_s, beta):
    B, S, _ = u.shape
    n_chunks = S // GMLP_CHUNK
    u = jax.nn.gelu(u)
    v = layer_norm(jax.nn.gelu(v), ln_gain)
    v = v.reshape(B, n_chunks, GMLP_CHUNK, GMLP_GROUPS, GMLP_GROUP_DIM)
    causal = jnp.tril(jnp.ones((GMLP_CHUNK, GMLP_CHUNK), dtype=bool))
    w = jnp.where(causal[None], w_s, jnp.zeros((), w_s.dtype))
    z = jnp.einsum('gts,bnsgc->bntgc', w, v) + b_s.T[:, :, None]
    y = u * z.reshape(B, S, D_GMLP)
    return rms_norm(y, beta)


def hgrn2_chunked(q, k, v, log_f):
    B, S, H, Dk = q.shape
    Dv = v.shape[-1]
    n_chunks = S // HGRN_CHUNK

    def to_chunks(t):
        return t.reshape(B, n_chunks, HGRN_CHUNK, H, t.shape[-1]).transpose(1, 0, 3, 2, 4)

    q, k, v, log_f = to_chunks(q), to_chunks(k), to_chunks(v), to_chunks(log_f)
    b = jnp.cumsum(log_f, axis=-2)
    b_last = b[..., -1:, :]
    q_dec = q * jnp.exp(b)
    k_inv = k * jnp.exp(-b)
    k_to_end = k * jnp.exp(b_last - b)
    causal = jnp.tril(jnp.ones((HGRN_CHUNK, HGRN_CHUNK), dtype=bool))
    scores = jnp.einsum('nbhid,nbhjd->nbhij', q_dec, k_inv)
    scores = jnp.where(causal, scores, jnp.zeros((), scores.dtype))
    o_intra = jnp.einsum('nbhij,nbhjv->nbhiv', scores, v)

    def step(state, inp):
        q_c, k_c, v_c, decay_c = inp
        o_c = jnp.einsum('bhid,bhdv->bhiv', q_c, state)
        state = decay_c[..., 0, :, None] * state + jnp.einsum('bhjd,bhjv->bhdv', k_c, v_c)
        return state, o_c

    state0 = jnp.zeros((B, H, Dk, Dv), jnp.float32)
    _, o_inter = lax.scan(step, state0, (q_dec, k_to_end, v, jnp.exp(b_last)))
    o = o_intra + o_inter
    return o.transpose(1, 0, 3, 2, 4).reshape(B, S, H, Dv)


def hgrn2_heads(q, f_logit, i, g, lower_bound, out_gain):
    B, S, _ = q.shape
    f32 = jnp.float32
    qk_shape = (B, S, HGRN_HEADS, HGRN_DK)
    qh = jax.nn.silu(q.astype(f32)).reshape(qk_shape)
    f = lower_bound + (1.0 - lower_bound) * jax.nn.sigmoid(f_logit.astype(f32))
    kh = (1.0 - f).reshape(qk_shape)
    log_f = jnp.log(f).reshape(qk_shape)
    vh = i.astype(f32).reshape(B, S, HGRN_HEADS, HGRN_DV)
    o = hgrn2_chunked(qh, kh, vh, log_f)
    o = o * lax.rsqrt(jnp.mean(o * o, axis=-1, keepdims=True) + EPS)
    o = o.reshape(B, S, D_HGRN) * out_gain.astype(f32) * jax.nn.silu(g.astype(f32))
    return o.astype(g.dtype)


def memory_cross_attention(h, mem, w_q, w_kv, w_o):
    B, S, _ = h.shape
    M = mem.shape[1]
    q = (h @ w_q).reshape(B, S, XATTN_HEADS, XATTN_HEAD_DIM)
    k, v = jnp.split(mem @ w_kv, 2, axis=-1)
    k = k.reshape(B, M, XATTN_HEADS, XATTN_HEAD_DIM)
    v = v.reshape(B, M, XATTN_HEADS, XATTN_HEAD_DIM)
    s = jnp.einsum('bshd,bmhd->bhsm', q, k).astype(jnp.float32) * (XATTN_HEAD_DIM ** -0.5)
    p = jax.nn.softmax(s, axis=-1).astype(v.dtype)
    o = jnp.einsum('bhsm,bmhd->bshd', p, v).reshape(B, S, D_MODEL)
    return o @ w_o


def routed_expert_ffn(xt, expert_ids, gates, w_gate, w_up, w_down):
    T, K = expert_ids.shape
    A = T * K
    n_blocks = -(-A // EXPERT_BLOCK) + N_EXPERTS
    flat_e = expert_ids.reshape(A)
    order = jnp.argsort(flat_e)
    sorted_e = flat_e[order]
    counts = jnp.zeros((N_EXPERTS,), jnp.int32).at[flat_e].add(1)
    padded = (counts + EXPERT_BLOCK - 1) // EXPERT_BLOCK * EXPERT_BLOCK
    seg_start = jnp.cumsum(counts) - counts
    pad_end = jnp.cumsum(padded)
    pad_start = pad_end - padded
    dest_sorted = pad_start[sorted_e] + (jnp.arange(A, dtype=jnp.int32) - seg_start[sorted_e])
    slot_token = jnp.full((n_blocks * EXPERT_BLOCK,), T, jnp.int32).at[dest_sorted].set(
        (order // K).astype(jnp.int32))
    x_pad = jnp.concatenate([xt, jnp.zeros((1, xt.shape[1]), xt.dtype)], axis=0)
    xb = x_pad[slot_token].reshape(n_blocks, EXPERT_BLOCK, xt.shape[1])
    block_start = jnp.arange(n_blocks, dtype=jnp.int32) * EXPERT_BLOCK
    block_e = jnp.minimum(jnp.searchsorted(pad_end, block_start, side='right'), N_EXPERTS - 1)

    def expert_block(args):
        xb_i, e = args
        hid = jax.nn.silu(xb_i @ w_gate[e]) * (xb_i @ w_up[e])
        return hid @ w_down[e]

    yb = lax.map(expert_block, (xb, block_e)).reshape(n_blocks * EXPERT_BLOCK, xt.shape[1])
    dest = jnp.zeros((A,), jnp.int32).at[order].set(dest_sorted)
    y = yb[dest].reshape(T, K, xt.shape[1])
    return jnp.einsum('tk,tkd->td', gates.astype(y.dtype), y)


def hierarchical_moe(x, w_rg, b_rg, w_re, b_re, w_gate, w_up, w_down):
    B, S, D = x.shape
    T = B * S
    f32 = jnp.float32
    xt = x.reshape(T, D)
    g_logits = (xt @ w_rg).astype(f32) + b_rg.astype(f32)
    g_prob = jax.nn.softmax(g_logits, axis=-1)
    _, g_sel = lax.top_k(g_logits, 1)
    g_gate = jnp.take_along_axis(g_prob, g_sel, axis=-1)
    e_logits = ((xt @ w_re).astype(f32) + b_re.astype(f32)).reshape(T, N_GROUPS, EXPERTS_PER_GROUP)
    e_in_group = jnp.take_along_axis(e_logits, g_sel[:, :, None], axis=1)[:, 0]
    top_vals, top_idx = lax.top_k(e_in_group, TOP_K_IN_GROUP)
    gates = jax.nn.softmax(top_vals, axis=-1) * g_gate
    expert_ids = g_sel * EXPERTS_PER_GROUP + top_idx
    y = routed_expert_ffn(xt, expert_ids, gates, w_gate, w_up, w_down)
    return y.reshape(B, S, D)


def setup_inputs(seed: int = 0) -> dict:
    key = jax.random.key(seed)
    ks = jax.random.split(key, 26)
    f32 = jnp.float32

    def normal(k, shape, scale):
        return jax.random.normal(k, shape, f32) * scale

    def gain(k, shape):
        return 1.0 + 0.02 * jax.random.normal(k, shape, f32)

    L = DEPTH
    return {
        "x": normal(ks[0], (BATCH, SEQ, D_MODEL), 1.0),
        "mem": normal(ks[1], (BATCH, N_MEM, D_MODEL), 1.0),
        "norm_mix": gain(ks[2], (L, D_MODEL)),
        "w_in": normal(ks[3], (L, D_MODEL, D_IN_PROJ), D_MODEL ** -0.5),
        "gmlp_ln": gain(ks[4], (L, D_GMLP)),
        "gmlp_w_spatial": normal(ks[5], (L, GMLP_GROUPS, GMLP_CHUNK, GMLP_CHUNK), GMLP_CHUNK ** -0.5),
        "gmlp_b_spatial": gain(ks[6], (L, GMLP_GROUPS, GMLP_CHUNK)),
        "gmlp_beta": gain(ks[7], (L, D_GMLP)),
        "hgrn_lb_logits": normal(ks[8], (L + 1, D_HGRN), 0.1),
        "hgrn_out_gain": gain(ks[9], (L, D_HGRN)),
        "w_out": normal(ks[10], (L, D_MIX, D_MODEL), D_MIX ** -0.5),
        "norm_xattn": gain(ks[11], (L, D_MODEL)),
        "norm_mem": gain(ks[12], (L, D_MODEL)),
        "w_xq": normal(ks[13], (L, D_MODEL, D_MODEL), D_MODEL ** -0.5),
        "w_xkv": normal(ks[14], (L, D_MODEL, 2 * D_MODEL), D_MODEL ** -0.5),
        "w_xo": normal(ks[15], (L, D_MODEL, D_MODEL), D_MODEL ** -0.5),
        "norm_ffn": gain(ks[16], (L, D_MODEL)),
        "w_router_group": normal(ks[17], (L, D_MODEL, N_GROUPS), D_MODEL ** -0.5),
        "b_router_group": normal(ks[18], (L, N_GROUPS), 0.01),
        "w_router_expert": normal(ks[19], (L, D_MODEL, N_EXPERTS), D_MODEL ** -0.5),
        "b_router_expert": normal(ks[20], (L, N_EXPERTS), 0.01),
        "w_expert_gate": normal(ks[21], (L, N_EXPERTS, D_MODEL, D_EXPERT), D_MODEL ** -0.5),
        "w_expert_up": normal(ks[22], (L, N_EXPERTS, D_MODEL, D_EXPERT), D_MODEL ** -0.5),
        "w_expert_down": normal(ks[23], (L, N_EXPERTS, D_EXPERT, D_MODEL), D_EXPERT ** -0.5),
        "norm_final": gain(ks[24], (D_MODEL,)),
    }


def reference(x, mem, norm_mix, w_in, gmlp_ln, gmlp_w_spatial, gmlp_b_spatial, gmlp_beta,
              hgrn_lb_logits, hgrn_out_gain, w_out, norm_xattn, norm_mem, w_xq, w_xkv, w_xo,
              norm_ffn, w_router_group, b_router_group, w_router_expert, b_router_expert,
              w_expert_gate, w_expert_up, w_expert_down, norm_final):
    lower_bounds = jnp.cumsum(jax.nn.softmax(hgrn_lb_logits.astype(jnp.float32), axis=0), axis=0)
    split_at = [D_GMLP, 2 * D_GMLP, 2 * D_GMLP + D_HGRN, 2 * D_GMLP + 2 * D_HGRN,
                2 * D_GMLP + 3 * D_HGRN]
    h = x
    for l in range(DEPTH):
        a = rms_norm(h, norm_mix[l])
        u, v, q, f_logit, i, g = jnp.split(a @ w_in[l], split_at, axis=-1)
        y_a = gmlp_heads(u, v, gmlp_ln[l], gmlp_w_spatial[l], gmlp_b_spatial[l], gmlp_beta[l])
        y_b = hgrn2_heads(q, f_logit, i, g, lower_bounds[l], hgrn_out_gain[l])
        h = h + jnp.concatenate([y_a, y_b], axis=-1) @ w_out[l]
        h = h + memory_cross_attention(rms_norm(h, norm_xattn[l]), rms_norm(mem, norm_mem[l]),
                                       w_xq[l], w_xkv[l], w_xo[l])
        h = h + hierarchical_moe(rms_norm(h, norm_ffn[l]), w_router_group[l], b_router_group[l],
                                 w_router_expert[l], b_router_expert[l], w_expert_gate[l],
                                 w_expert_up[l], w_expert_down[l])
    return rms_norm(h, norm_final)
```

```cpp
#define FAST_MASK 0xFFFF
#include <hip/hip_runtime.h>
#include <stdint.h>
#include <stdio.h>

typedef unsigned short bf16;
constexpr int B_ = 32, S_ = 2048, D_ = 1024, T_ = B_ * S_;
constexpr int NPROJ = 3072, DG = 512, DH = 512, NMEM = 256, MROWS = B_ * NMEM;
constexpr int NE = 32, DEXP = 512, EBLK = 256, NSLOT = 2 * T_ + NE * EBLK, NBLK = NSLOT / EBLK;
constexpr float EPS = 1e-6f;

constexpr size_t MiB = 1u << 20;
constexpr size_t WS_CTL = 0;
constexpr size_t WS_TOKE = 1 * MiB, WS_TOKG = WS_TOKE + 512 * 1024, WS_LPOS = WS_TOKG + 512 * 1024, WS_TOKSLOT = WS_LPOS + 512 * 1024;
constexpr size_t WS_SLOTTOK = 3 * MiB, WS_SLOTGATE = 4 * MiB, WS_HIST = 5 * MiB, WS_BASE = WS_HIST + 64 * 1024, WS_SMALL = WS_BASE + 64 * 1024;
constexpr size_t WS_SSQ1 = 15 * MiB + 512 * 1024;
constexpr size_t WS_INVRS = 15 * MiB + 512 * 1024;
constexpr size_t WS_WSP = 15 * MiB;
constexpr size_t WS_WRF = 12 * MiB, WS_RS = 13 * MiB, WS_SLOTRS = 14 * MiB;
constexpr size_t WS_WIN = 16 * MiB, WS_WOUT = 22 * MiB, WS_WXQ = 24 * MiB, WS_WXKV = 26 * MiB, WS_WXO = 30 * MiB, WS_WGU = 32 * MiB, WS_WDN = 96 * MiB;
constexpr size_t WS_A = 128 * MiB, WS_Y = 256 * MiB, WS_MEMN = 386 * MiB, WS_KV = 402 * MiB, WS_PROJ = 434 * MiB;
constexpr size_t WS_HID = WS_PROJ, WS_YB = WS_PROJ + 136 * MiB, WS_KVOLD = 850 * MiB, WS_END = 882 * MiB;
constexpr size_t WS_KB = WS_KV, WS_VT = WS_KV + 16 * MiB;
constexpr int SM_PADSTART = 0, SM_CNTEND = 64, SM_BLOCKE = 128;

__device__ __forceinline__ float bf2f(bf16 v) { return __uint_as_float(((unsigned)v) << 16); }
__device__ __forceinline__ bf16 f2bf(float f) { unsigned u = __float_as_uint(f); u += 0x7fffu + ((u >> 16) & 1u); return (bf16)(u >> 16); }
__device__ __forceinline__ float wave_sum(float v) {
#pragma unroll
    for (int o = 1; o < 64; o <<= 1) v += __shfl_xor(v, o);
    return v;
}
__device__ __forceinline__ float row16_sum_dpp(float v) {
    v += __int_as_float(__builtin_amdgcn_update_dpp(0, __float_as_int(v), 0xB1, 0xf, 0xf, true));
    v += __int_as_float(__builtin_amdgcn_update_dpp(0, __float_as_int(v), 0x4E, 0xf, 0xf, true));
    v += __int_as_float(__builtin_amdgcn_update_dpp(0, __float_as_int(v), 0x141, 0xf, 0xf, true));
    v += __int_as_float(__builtin_amdgcn_update_dpp(0, __float_as_int(v), 0x140, 0xf, 0xf, true));
    return v;
}
__device__ __forceinline__ float wave_sum_dpp(float v) {
    v = row16_sum_dpp(v);
    const float a = __int_as_float(__builtin_amdgcn_readlane(__float_as_int(v), 0)), b = __int_as_float(__builtin_amdgcn_readlane(__float_as_int(v), 16));
    const float c = __int_as_float(__builtin_amdgcn_readlane(__float_as_int(v), 32)), d = __int_as_float(__builtin_amdgcn_readlane(__float_as_int(v), 48));
    return (a + b) + (c + d);
}
__device__ __forceinline__ float wave_max(float v) {
#pragma unroll
    for (int o = 1; o < 64; o <<= 1) v = fmaxf(v, __shfl_xor(v, o));
    return v;
}
__device__ __forceinline__ float gelu_tanh(float x) { const float u = 0.7978845608028654f * (x + 0.044715f * x * x * x); return 0.5f * x * (1.0f + tanhf(u)); }
__device__ __forceinline__ float sigmoidf_(float x) { return 1.0f / (1.0f + expf(-x)); }
__device__ __forceinline__ float siluf_(float x) { return x / (1.0f + expf(-x)); }

__global__ __launch_bounds__(256) void k_rmsnorm1024(const float* __restrict__ x, const float* __restrict__ gain, bf16* __restrict__ out, int rows, int rpad) {
    const int w = (int)((blockIdx.x * 256u + threadIdx.x) >> 6), lane = threadIdx.x & 63;
    if (w >= rows) return;
    const float4* xr = (const float4*)(x + (size_t)w * 1024);
    float4 v[4]; float s = 0.f;
#pragma unroll
    for (int j = 0; j < 4; ++j) { v[j] = xr[lane + 64 * j]; s += v[j].x * v[j].x + v[j].y * v[j].y + v[j].z * v[j].z + v[j].w * v[j].w; }
    s = wave_sum(s);
    const float r = 1.0f / sqrtf(s * (1.0f / 1024.0f) + EPS);
#pragma unroll
    for (int j = 0; j < 4; ++j) {
        const float4 g = ((const float4*)gain)[lane + 64 * j];
        ushort4 o; o.x = f2bf(v[j].x * r * g.x); o.y = f2bf(v[j].y * r * g.y); o.z = f2bf(v[j].z * r * g.z); o.w = f2bf(v[j].w * r * g.w);
        ((ushort4*)(out + (size_t)w * 1024))[lane + 64 * j] = o;
    }
}

struct ALPlain { const bf16* A; int lda; int pad; __device__ const bf16* row(int r) const { return A + (size_t)r * lda; } };
struct ALGather { const bf16* A; const int* idx; int lda; int pad; __device__ const bf16* row(int r) const { return A + (size_t)idx[r] * lda; } };
struct BLPlain { const float* W; int ldb; int pad; __device__ bool valid(int) const { return true; }
    __device__ float4 ld(int  , int k, int n0, int c4) const { return *(const float4*)(W + (size_t)k * ldb + n0 + c4); } };
struct BLMoe1 { const float* Wg; const float* Wu; const int* block_e;
    __device__ bool valid(int tm) const { return block_e[tm >> 2] >= 0; }
    __device__ float4 ld(int tm, int k, int n0  , int c4) const { const int e = block_e[tm >> 2]; const int tn = n0 >> 6; const float* W = (c4 < 32) ? Wg : Wu; const int c = 32 * tn + (c4 & 31);
        return *(const float4*)(W + ((size_t)e * 1024 + k) * 512 + c); } };
struct BLMoe2 { const float* Wd; const int* block_e;
    __device__ bool valid(int tm) const { return block_e[tm >> 2] >= 0; }
    __device__ float4 ld(int tm, int k, int n0, int c4) const { const int e = block_e[tm >> 2]; return *(const float4*)(Wd + ((size_t)e * 512 + k) * 1024 + n0 + c4); } };
struct EPBf16 { bf16* O; int ldc; int pad; __device__ void st(int r, int c, const float (&a)[4]) const { ushort4 o; o.x = f2bf(a[0]); o.y = f2bf(a[1]); o.z = f2bf(a[2]); o.w = f2bf(a[3]); *(ushort4*)(O + (size_t)r * ldc + c) = o; } };
struct EPRes { const float* R; float* O; int ldc; int pad; __device__ void st(int r, int c, const float (&a)[4]) const { const float4 b = *(const float4*)(R + (size_t)r * ldc + c); *(float4*)(O + (size_t)r * ldc + c) = make_float4(b.x + a[0], b.y + a[1], b.z + a[2], b.w + a[3]); } };
struct EPScale { bf16* O; const float* sc; int ldc; int pad; __device__ void st(int r, int c, const float (&a)[4]) const { const float s = sc[r]; ushort4 o; o.x = f2bf(a[0] * s); o.y = f2bf(a[1] * s); o.z = f2bf(a[2] * s); o.w = f2bf(a[3] * s); *(ushort4*)(O + (size_t)r * ldc + c) = o; } };

template <class AL, class BL, class EP, bool MOE1>
__global__ __launch_bounds__(256) void k_gemm_naive(AL al, BL bl, EP ep, bf16* hid, const float* rsl, int K, int kpad) {
    __shared__ float As[16][68];
    __shared__ float Bs[16][64];
    const int tid = threadIdx.x, tx = tid & 15, ty = tid >> 4, tm = blockIdx.y, tn = blockIdx.x;
    if (!bl.valid(tm)) return;
    float acc[4][4];
#pragma unroll
    for (int i = 0; i < 4; ++i)
#pragma unroll
        for (int j = 0; j < 4; ++j) acc[i][j] = 0.f;
    const int ar = tid >> 2, ak = (tid & 3) * 4;
    const int bk = tid >> 4, bc = (tid & 15) * 4;
    const bf16* arow = al.row(tm * 64 + ar);
    int cc[4];
#pragma unroll
    for (int j = 0; j < 4; ++j) cc[j] = MOE1 ? ((j < 2) ? 2 * tx + j : 32 + 2 * tx + (j - 2)) : 4 * tx + j;
    for (int k0 = 0; k0 < K; k0 += 16) {
        const ushort4 av = *(const ushort4*)(arow + k0 + ak);
        const float4 bv = bl.ld(tm, k0 + bk, tn * 64, bc);
        __syncthreads();
        As[ak + 0][ar] = bf2f(av.x); As[ak + 1][ar] = bf2f(av.y); As[ak + 2][ar] = bf2f(av.z); As[ak + 3][ar] = bf2f(av.w);
        *(float4*)&Bs[bk][bc] = bv;
        __syncthreads();
#pragma unroll
        for (int k = 0; k < 16; ++k) {
            const float4 a4 = *(const float4*)&As[k][ty * 4];
            const float a[4] = {a4.x, a4.y, a4.z, a4.w};
            float b[4];
#pragma unroll
            for (int j = 0; j < 4; ++j) b[j] = Bs[k][cc[j]];
#pragma unroll
            for (int i = 0; i < 4; ++i)
#pragma unroll
                for (int j = 0; j < 4; ++j) acc[i][j] += a[i] * b[j];
        }
    }
#pragma unroll
    for (int i = 0; i < 4; ++i) {
        const int r = tm * 64 + ty * 4 + i;
        if (MOE1) {
            const float sc = rsl[r]; const float h0 = siluf_(acc[i][0] * sc) * (acc[i][2] * sc), h1 = siluf_(acc[i][1] * sc) * (acc[i][3] * sc);
            ushort2 o; o.x = f2bf(h0); o.y = f2bf(h1);
            *(ushort2*)(hid + (size_t)r * 512 + tn * 32 + 2 * tx) = o;
        } else ep.st(r, tn * 64 + 4 * tx, acc[i]);
    }
}

__global__ __launch_bounds__(256) void k_gmlp_ln(const bf16* __restrict__ proj, const float* __restrict__ ln_gain, float* __restrict__ vln) {
    const int w = (int)((blockIdx.x * 256u + threadIdx.x) >> 6), lane = threadIdx.x & 63;
    const bf16* p = proj + (size_t)w * NPROJ + 512 + lane * 8;
    const uint4 raw = *(const uint4*)p; const unsigned rw[4] = {raw.x, raw.y, raw.z, raw.w};
    float g[8]; float s = 0.f;
#pragma unroll
    for (int i = 0; i < 4; ++i) { g[2 * i] = gelu_tanh(bf2f((bf16)(rw[i] & 0xffff))); g[2 * i + 1] = gelu_tanh(bf2f((bf16)(rw[i] >> 16))); s += g[2 * i] + g[2 * i + 1]; }
    const float mean = wave_sum(s) * (1.0f / 512.0f); float q = 0.f;
#pragma unroll
    for (int i = 0; i < 8; ++i) { g[i] -= mean; q += g[i] * g[i]; }
    const float rstd = 1.0f / sqrtf(wave_sum(q) * (1.0f / 512.0f) + EPS);
#pragma unroll
    for (int i = 0; i < 8; ++i) vln[(size_t)w * 512 + lane * 8 + i] = g[i] * rstd * ln_gain[lane * 8 + i];
}
__global__ __launch_bounds__(256) void k_gmlp_spatial(const bf16* __restrict__ proj, const float* __restrict__ vln, const float* __restrict__ Wsp, const float* __restrict__ bsp, float* __restrict__ ya) {
    const size_t gid = (size_t)blockIdx.x * 256 + threadIdx.x; const int t = (int)(gid >> 9), ch = (int)(gid & 511), g = ch >> 7, tt = t & 127, base = t - tt;
    const float* wrow = Wsp + ((size_t)g * 128 + tt) * 128;
    float z = bsp[g * 128 + tt];
    for (int s = 0; s <= tt; ++s) z += wrow[s] * vln[(size_t)(base + s) * 512 + ch];
    const float u = gelu_tanh(bf2f(proj[(size_t)t * NPROJ + ch]));
    ya[(size_t)t * 512 + ch] = u * z;
}
__global__ __launch_bounds__(256) void k_rmsnorm512(const float* __restrict__ ya, const float* __restrict__ beta, bf16* __restrict__ y) {
    const int w = (int)((blockIdx.x * 256u + threadIdx.x) >> 6), lane = threadIdx.x & 63;
    float v[8]; float s = 0.f;
#pragma unroll
    for (int i = 0; i < 8; ++i) { v[i] = ya[(size_t)w * 512 + lane * 8 + i]; s += v[i] * v[i]; }
    const float r = 1.0f / sqrtf(wave_sum(s) * (1.0f / 512.0f) + EPS);
#pragma unroll
    for (int i = 0; i < 8; ++i) y[(size_t)w * 1024 + lane * 8 + i] = f2bf(v[i] * r * beta[lane * 8 + i]);
}
__global__ __launch_bounds__(128) void k_hgrn_rec(const bf16* __restrict__ proj, const float* __restrict__ lb_logits, float* __restrict__ o) {
    __shared__ float sq[16][128], sf[16][128], sk[16][128];
    const int b = blockIdx.x >> 2, h = blockIdx.x & 3, tid = threadIdx.x;
    const float l0 = lb_logits[h * 128 + tid], l1 = lb_logits[512 + h * 128 + tid];
    const float mx = fmaxf(l0, l1), e0 = expf(l0 - mx), e1 = expf(l1 - mx), lb = e0 / (e0 + e1);
    float S[128];
#pragma unroll
    for (int d = 0; d < 128; ++d) S[d] = 0.f;
    for (int t0 = 0; t0 < S_; t0 += 16) {
        __syncthreads();
        for (int i = 0; i < 16; ++i) {
            const size_t row = (size_t)b * S_ + t0 + i;
            const float ql = bf2f(proj[row * NPROJ + 1024 + h * 128 + tid]), fl = bf2f(proj[row * NPROJ + 1536 + h * 128 + tid]);
            const float f = lb + (1.0f - lb) * sigmoidf_(fl);
            sq[i][tid] = siluf_(ql); sf[i][tid] = f; sk[i][tid] = 1.0f - f;
        }
        __syncthreads();
        for (int i = 0; i < 16; ++i) {
            const size_t row = (size_t)b * S_ + t0 + i;
            const float vv = bf2f(proj[row * NPROJ + 2048 + h * 128 + tid]);
            float acc = 0.f;
#pragma unroll
            for (int d = 0; d < 128; ++d) { S[d] = sf[i][d] * S[d] + sk[i][d] * vv; acc += S[d] * sq[i][d]; }
            o[row * 512 + h * 128 + tid] = acc;
        }
    }
}
__global__ __launch_bounds__(256) void k_hgrn_out(const float* __restrict__ o, const bf16* __restrict__ proj, const float* __restrict__ out_gain, bf16* __restrict__ y) {
    const int w = (int)((blockIdx.x * 256u + threadIdx.x) >> 6), lane = threadIdx.x & 63;
    float v[8]; float s = 0.f;
#pragma unroll
    for (int i = 0; i < 8; ++i) { v[i] = o[(size_t)w * 512 + lane * 8 + i]; s += v[i] * v[i]; }
    s += __shfl_xor(s, 1); s += __shfl_xor(s, 2); s += __shfl_xor(s, 4); s += __shfl_xor(s, 8);
    const float r = 1.0f / sqrtf(s * (1.0f / 128.0f) + EPS);
#pragma unroll
    for (int i = 0; i < 8; ++i) { const int ch = lane * 8 + i; const float g = bf2f(proj[(size_t)w * NPROJ + 2560 + ch]);
        y[(size_t)w * 1024 + 512 + ch] = f2bf(v[i] * r * out_gain[ch] * siluf_(g)); }
}
__global__ __launch_bounds__(256) void k_attn_naive(const bf16* __restrict__ q, const bf16* __restrict__ kv, bf16* __restrict__ o) {
    __shared__ float sq[4][256], sp[4][256];
    const int wv = threadIdx.x >> 6, lane = threadIdx.x & 63; const int w = blockIdx.x * 4 + wv; const int t = w >> 2, h = w & 3, b = t / S_;
#pragma unroll
    for (int j = 0; j < 4; ++j) sq[wv][lane + 64 * j] = bf2f(q[(size_t)t * 1024 + h * 256 + lane + 64 * j]);
    __syncthreads();
    float sc[4]; float mx = -1e30f;
#pragma unroll
    for (int j = 0; j < 4; ++j) {
        const int m = lane + 64 * j; const bf16* kr = kv + (size_t)(b * NMEM + m) * 2048 + h * 256; float s = 0.f;
        for (int d = 0; d < 256; d += 8) { const uint4 raw = *(const uint4*)(kr + d); const unsigned rw[4] = {raw.x, raw.y, raw.z, raw.w};
#pragma unroll
            for (int i = 0; i < 4; ++i) s += sq[wv][d + 2 * i] * bf2f((bf16)(rw[i] & 0xffff)) + sq[wv][d + 2 * i + 1] * bf2f((bf16)(rw[i] >> 16)); }
        sc[j] = s * 0.0625f; mx = fmaxf(mx, sc[j]);
    }
    mx = wave_max(mx); float sum = 0.f;
#pragma unroll
    for (int j = 0; j < 4; ++j) { sc[j] = expf(sc[j] - mx); sum += sc[j]; }
    sum = wave_sum(sum); const float inv = 1.0f / sum;
#pragma unroll
    for (int j = 0; j < 4; ++j) sp[wv][lane + 64 * j] = sc[j] * inv;
    __syncthreads();
    float acc[4] = {0.f, 0.f, 0.f, 0.f};
    for (int m = 0; m < NMEM; ++m) { const float p = sp[wv][m]; const bf16* vr = kv + (size_t)(b * NMEM + m) * 2048 + 1024 + h * 256;
#pragma unroll
        for (int j = 0; j < 4; ++j) acc[j] += p * bf2f(vr[lane + 64 * j]); }
#pragma unroll
    for (int j = 0; j < 4; ++j) o[(size_t)t * 1024 + h * 256 + lane + 64 * j] = f2bf(acc[j]);
}
__global__ __launch_bounds__(256) void k_router_naive(const float* __restrict__ h2, const float* __restrict__ gain, const float* __restrict__ wrg, const float* __restrict__ brg,
                                                       const float* __restrict__ wre, const float* __restrict__ bre, bf16* __restrict__ xn, int* __restrict__ tok_e, float* __restrict__ tok_g, float* __restrict__ rs) {
    const int w = (int)((blockIdx.x * 256u + threadIdx.x) >> 6), lane = threadIdx.x & 63;
    const float4* xr = (const float4*)(h2 + (size_t)w * 1024);
    float x[16]; float s = 0.f;
#pragma unroll
    for (int j = 0; j < 4; ++j) { const float4 v = xr[lane + 64 * j]; x[4 * j] = v.x; x[4 * j + 1] = v.y; x[4 * j + 2] = v.z; x[4 * j + 3] = v.w; s += v.x * v.x + v.y * v.y + v.z * v.z + v.w * v.w; }
    const float r = 1.0f / sqrtf(wave_sum(s) * (1.0f / 1024.0f) + EPS);
#pragma unroll
    for (int j = 0; j < 4; ++j) { const float4 g = ((const float4*)gain)[lane + 64 * j]; ushort4 o; o.x = f2bf(x[4 * j] * g.x); o.y = f2bf(x[4 * j + 1] * g.y); o.z = f2bf(x[4 * j + 2] * g.z); o.w = f2bf(x[4 * j + 3] * g.w); ((ushort4*)(xn + (size_t)w * 1024))[lane + 64 * j] = o;
        x[4 * j] *= r * g.x; x[4 * j + 1] *= r * g.y; x[4 * j + 2] *= r * g.z; x[4 * j + 3] *= r * g.w; }
    float gl[4], el[32];
#pragma unroll
    for (int o = 0; o < 4; ++o) gl[o] = 0.f;
#pragma unroll
    for (int o = 0; o < 32; ++o) el[o] = 0.f;
#pragma unroll
    for (int j = 0; j < 4; ++j)
#pragma unroll
        for (int i = 0; i < 4; ++i) { const int k = (lane + 64 * j) * 4 + i; const float xv = x[4 * j + i];
            const float4 wg = *(const float4*)(wrg + (size_t)k * 4); gl[0] += xv * wg.x; gl[1] += xv * wg.y; gl[2] += xv * wg.z; gl[3] += xv * wg.w;
#pragma unroll
            for (int o4 = 0; o4 < 8; ++o4) { const float4 we = *(const float4*)(wre + (size_t)k * 32 + o4 * 4); el[o4 * 4] += xv * we.x; el[o4 * 4 + 1] += xv * we.y; el[o4 * 4 + 2] += xv * we.z; el[o4 * 4 + 3] += xv * we.w; } }
#pragma unroll
    for (int o = 0; o < 4; ++o) gl[o] = wave_sum(gl[o]) + brg[o];
#pragma unroll
    for (int o = 0; o < 32; ++o) el[o] = wave_sum(el[o]) + bre[o];
    int gs = 0; float gm = gl[0];
#pragma unroll
    for (int o = 1; o < 4; ++o) if (gl[o] > gm) { gm = gl[o]; gs = o; }
    float gsum = 0.f;
#pragma unroll
    for (int o = 0; o < 4; ++o) gsum += expf(gl[o] - gm);
    const float ggate = 1.0f / gsum;
    float ev[8];
#pragma unroll
    for (int i = 0; i < 8; ++i) { float v = el[i];
#pragma unroll
        for (int g2 = 1; g2 < 4; ++g2) v = (gs == g2) ? el[g2 * 8 + i] : v; ev[i] = v; }
    int i0 = 0; float v0 = ev[0];
#pragma unroll
    for (int i = 1; i < 8; ++i) if (ev[i] > v0) { v0 = ev[i]; i0 = i; }
    int i1 = -1; float v1 = -3.0e38f;
#pragma unroll
    for (int i = 0; i < 8; ++i) if (i != i0 && ev[i] > v1) { v1 = ev[i]; i1 = i; }
    const float p0 = 1.0f / (1.0f + expf(v1 - v0)), p1 = 1.0f - p0;
    if (lane == 0) { rs[w] = r; tok_e[w * 2] = gs * 8 + i0; tok_e[w * 2 + 1] = gs * 8 + i1; tok_g[w * 2] = p0 * ggate; tok_g[w * 2 + 1] = p1 * ggate; }
}
__global__ __launch_bounds__(256) void k_route_hist(const int* __restrict__ tok_e, int* __restrict__ lpos, int* __restrict__ hist) {
    __shared__ int h[32];
    const int tid = threadIdx.x, t = blockIdx.x * 256 + tid;
    if (tid < 32) h[tid] = 0;
    __syncthreads();
    lpos[t * 2] = atomicAdd(&h[tok_e[t * 2]], 1); lpos[t * 2 + 1] = atomicAdd(&h[tok_e[t * 2 + 1]], 1);
    __syncthreads();
    if (tid < 32) hist[blockIdx.x * 32 + tid] = h[tid];
}
__global__ __launch_bounds__(256) void k_route_scan(const int* __restrict__ hist, int* __restrict__ base, int* __restrict__ small) {
    __shared__ int tot[32], ps[33];
    const int tid = threadIdx.x;
    if (tid < 32) { int s = 0; for (int b = 0; b < 256; ++b) s += hist[b * 32 + tid]; tot[tid] = s; }
    __syncthreads();
    if (tid == 0) { int run = 0; for (int e = 0; e < 32; ++e) { ps[e] = run; run += (tot[e] + EBLK - 1) / EBLK * EBLK; } ps[32] = run; }
    __syncthreads();
    if (tid < 32) { int run = ps[tid]; for (int b = 0; b < 256; ++b) { base[b * 32 + tid] = run; run += hist[b * 32 + tid]; } small[SM_CNTEND + tid] = run; }
    if (tid < 33) small[SM_PADSTART + tid] = ps[tid];
    for (int blk = tid; blk < NBLK; blk += 256) { const int st = blk * EBLK; int e = -1; for (int j = 0; j < 32; ++j) if (st >= ps[j] && st < ps[j + 1]) e = j; small[SM_BLOCKE + blk] = e; }
}
__global__ __launch_bounds__(256) void k_route_fill(const int* __restrict__ tok_e, const float* __restrict__ tok_g, const int* __restrict__ lpos, const int* __restrict__ base, const int* __restrict__ small,
                                                     int* __restrict__ slot_tok, float* __restrict__ slot_gate, int* __restrict__ tok_slot, const float* __restrict__ rs, float* __restrict__ slot_rs) {
    const int tid = threadIdx.x, t = blockIdx.x * 256 + tid;
#pragma unroll
    for (int k = 0; k < 2; ++k) { const int e = tok_e[t * 2 + k]; const int slot = base[blockIdx.x * 32 + e] + lpos[t * 2 + k]; slot_tok[slot] = t; slot_gate[slot] = tok_g[t * 2 + k]; slot_rs[slot] = rs[t]; tok_slot[t * 2 + k] = slot; }
    if (blockIdx.x < 32) { const int e = blockIdx.x; for (int s = small[SM_CNTEND + e] + tid; s < small[SM_PADSTART + e + 1]; s += 256) { slot_tok[s] = T_; slot_gate[s] = 0.f; slot_rs[s] = 0.f; } }
}
__global__ __launch_bounds__(256) void k_final(float* __restrict__ h2out, const bf16* __restrict__ yb, const int* __restrict__ tok_slot, const float* __restrict__ gain) {
    const int w = (int)((blockIdx.x * 256u + threadIdx.x) >> 6), lane = threadIdx.x & 63;
    const int s0 = tok_slot[w * 2], s1 = tok_slot[w * 2 + 1];
    float4* xr = (float4*)(h2out + (size_t)w * 1024);
    float4 v[4]; float s = 0.f;
#pragma unroll
    for (int j = 0; j < 4; ++j) { v[j] = xr[lane + 64 * j];
        const ushort4 a = ((const ushort4*)(yb + (size_t)s0 * 1024))[lane + 64 * j], c = ((const ushort4*)(yb + (size_t)s1 * 1024))[lane + 64 * j];
        v[j].x += bf2f(a.x) + bf2f(c.x); v[j].y += bf2f(a.y) + bf2f(c.y); v[j].z += bf2f(a.z) + bf2f(c.z); v[j].w += bf2f(a.w) + bf2f(c.w);
        s += v[j].x * v[j].x + v[j].y * v[j].y + v[j].z * v[j].z + v[j].w * v[j].w; }
    const float r = 1.0f / sqrtf(wave_sum(s) * (1.0f / 1024.0f) + EPS);
#pragma unroll
    for (int j = 0; j < 4; ++j) { const float4 g = ((const float4*)gain)[lane + 64 * j]; xr[lane + 64 * j] = make_float4(v[j].x * r * g.x, v[j].y * r * g.y, v[j].z * r * g.z, v[j].w * r * g.w); }
}

#include <type_traits>
namespace pg8 {
#define PG8_LAS __attribute__((address_space(3)))
typedef unsigned short bf16_t;
typedef short bf16x8 __attribute__((ext_vector_type(8)));
typedef float f32x4 __attribute__((ext_vector_type(4)));
typedef unsigned u32x4 __attribute__((ext_vector_type(4)));
constexpr int BM = 256, BK = 64, HALF = 128, HTB = HALF * BK * 2  , STAGE_BYTES = 8 * HTB, NXCD = 8, WGM = 8;

__host__ __device__ __forceinline__ int lds_byte(int r, int c) { const int st = (r >> 4) * 2 + (c >> 5), rr = r & 15, cc = c & 31, ob = rr * 64 + cc * 2; return st * 1024 + (ob ^ (((ob >> 9) & 1) << 5)); }
__host__ __device__ __forceinline__ void stage_rc(int b, int& R, int& C) { const int st = b / 1024, sb = b % 1024, swz = sb ^ (((sb >> 9) & 1) << 5); R = (st >> 1) * 16 + swz / 64; C = (st & 1) * 32 + (swz % 64) / 2; }
__host__ __device__ __forceinline__ int perm32(int rho) { const int n = rho >> 4, i = rho & 15; return 8 * (i >> 2) + 4 * n + (i & 3); }

struct Unit { int pm, pn; };
struct Gemm { const bf16_t* A; const bf16_t* Bt; const int* gidx; int M, N, K; };

struct StaticOrder {
    int nM, nN, nwg, G, c, wgm;
    __host__ __device__ void init(int M, int N, int G_, int c_, int wgm_ = WGM) { nM = M / BM; nN = N / BM; nwg = nM * nN; G = G_; c = c_; wgm = wgm_; }
    __host__ __device__ bool next(int i, Unit& u) const {
        const long L = (long)i * G + c; if (L >= nwg) return false;
        int wgid = (int)L; { const int q = nwg / NXCD, r = nwg % NXCD, xcd = wgid % NXCD, off = wgid / NXCD; wgid = (xcd < r ? xcd * (q + 1) : r * (q + 1) + (xcd - r) * q) + off; }
        const int nig = wgm * nN, gid = wgid / nig, fm = gid * wgm, gsz = (nM - fm) < wgm ? (nM - fm) : wgm;
        u.pm = fm + ((wgid % nig) % gsz); u.pn = (wgid % nig) / gsz; return true;
    }
    __device__ __forceinline__ void a_ready(const Unit&) const {}
    __device__ __forceinline__ void done(const Unit&) const {}
};
struct MoeOrder {
    StaticOrder so; const int* block_e;
    __device__ void init(int nblk_used, int G_, int c_, const int* be, int wgm_ = WGM) { so.init(nblk_used * BM, 4 * BM, G_, c_, wgm_); block_e = be; }
    __device__ bool next(int i, Unit& u) const { if (!so.next(i, u)) return false; u.pn = block_e[u.pm] * 4 + u.pn; return true; }
    __device__ __forceinline__ void a_ready(const Unit&) const {}
    __device__ __forceinline__ void done(const Unit&) const {}
};

__device__ __forceinline__ unsigned cvt_pk_bf16(float lo, float hi) { unsigned r; asm volatile("v_cvt_pk_bf16_f32 %0, %1, %2" : "=v"(r) : "v"(lo), "v"(hi)); return r; }
__device__ __forceinline__ float clamp_fp8(float v) { return __builtin_amdgcn_fmed3f(v, -448.0f, 448.0f); }
__device__ __forceinline__ unsigned cvt4_fp8(float a, float b, float c, float d) { int w = 0; w = __builtin_amdgcn_cvt_pk_fp8_f32(clamp_fp8(a), clamp_fp8(b), w, false); w = __builtin_amdgcn_cvt_pk_fp8_f32(clamp_fp8(c), clamp_fp8(d), w, true); return (unsigned)w; }
__device__ __forceinline__ float fast_silu(float x) { return x * __builtin_amdgcn_rcpf(1.0f + __builtin_amdgcn_exp2f(-1.4426950408889634f * x)); }

struct EpiBf16P {
    static constexpr bool PERM = true, ADJ = false, AFTER_DRAIN = false, NEEDS_NOP = true;
    bf16_t* O; int ldc; int pad;
    __device__ __forceinline__ void operator()(const f32x4 (&acc)[2][2][4][2], const Unit& u, int wr, int wc, int fr, int fq) const {
        const int row0 = u.pm * BM + wr * 64 + fr, col0 = u.pn * BM + wc * 32 + 8 * fq;
#pragma unroll
        for (int ai = 0; ai < 2; ++ai)
#pragma unroll
            for (int m = 0; m < 4; ++m) { bf16_t* rowp = O + (size_t)(row0 + ai * HALF + m * 16) * ldc + col0;
#pragma unroll
                for (int bj = 0; bj < 2; ++bj) { const f32x4 v0 = acc[ai][bj][m][0], v1 = acc[ai][bj][m][1];
                    u32x4 w; w.x = cvt_pk_bf16(v0[0], v0[1]); w.y = cvt_pk_bf16(v0[2], v0[3]); w.z = cvt_pk_bf16(v1[0], v1[1]); w.w = cvt_pk_bf16(v1[2], v1[3]);
                    *(u32x4*)(rowp + bj * HALF) = w; } }
    }
};
struct EpiBf16PT {
    static constexpr bool PERM = true, ADJ = true, AFTER_DRAIN = false, NEEDS_NOP = true;
    bf16_t* O; int ldc; int pad;
    __device__ __forceinline__ void operator()(const f32x4 (&acc)[2][2][4][2], const Unit& u, int wr, int wc, int fr, int fq, PG8_LAS unsigned char* xs) const {
        const int l_ = fq * 16 + fr, r_ = l_ >> 3, c_ = l_ & 7;
        const int woff = fr * 128 + ((fq ^ (fr & 7)) << 4), roff = r_ * 128 + ((c_ ^ r_) << 4);
        bf16_t* gp = O + (size_t)(u.pm * BM + wr * 64 + r_) * ldc + u.pn * BM + wc * 64 + 8 * c_;
        u32x4 pa, pb;
#pragma unroll
        for (int s_ = 0; s_ < 8; ++s_) { const int ai = s_ >> 2, m = s_ & 3;
#pragma unroll
            for (int bj = 0; bj < 2; ++bj) { const f32x4 v0 = acc[ai][bj][m][0], v1 = acc[ai][bj][m][1];
                u32x4 w; w.x = cvt_pk_bf16(v0[0], v0[1]); w.y = cvt_pk_bf16(v0[2], v0[3]); w.z = cvt_pk_bf16(v1[0], v1[1]); w.w = cvt_pk_bf16(v1[2], v1[3]);
                *(PG8_LAS u32x4*)(xs + (woff ^ (bj << 6))) = w; }
            const u32x4 a = *(const PG8_LAS u32x4*)(xs + roff), b = *(const PG8_LAS u32x4*)(xs + roff + 1024);
            if (s_ > 0) { bf16_t* rp = gp + (size_t)(((s_ - 1) >> 2) * HALF + ((s_ - 1) & 3) * 16) * ldc; *(u32x4*)rp = pa; *(u32x4*)(rp + (size_t)8 * ldc) = pb; }
            pa = a; pb = b; }
        { bf16_t* rp = gp + (size_t)(HALF + 3 * 16) * ldc; *(u32x4*)rp = pa; *(u32x4*)(rp + (size_t)8 * ldc) = pb; }
    }
};
struct KvOrder {
    int G, c, tMem, tW;
    __device__ bool next(int i, Unit& u) const { const int L = i * G + c; if (L >= 256) return false;
        if (L < 128) { u.pm = tMem + (L >> 2); u.pn = tW + (L & 3); } else { const int l2 = L - 128; u.pm = tW + 4 + (l2 >> 5); u.pn = tMem + (l2 & 31); } return true; }
    __device__ __forceinline__ void a_ready(const Unit&) const {}
    __device__ __forceinline__ void done(const Unit&) const {}
};
struct EpiKV {
    static constexpr bool PERM = true, ADJ = false, AFTER_DRAIN = false, NEEDS_NOP = false;
    bf16_t* KB; bf16_t* VT; int tMem, tW;
    __device__ __forceinline__ void operator()(const f32x4 (&acc)[2][2][4][2], const Unit& u, int wr, int wc, int fr, int fq) const {
        const bool isk = u.pm >= tMem; const int pm = isk ? u.pm - tMem : u.pm - (tW + 4), pn = isk ? u.pn - tW : u.pn - tMem;
        bf16_t* O = isk ? KB : VT; const int ldc = isk ? 1024 : 8192;
        const int row0 = pm * BM + wr * 64 + fr, col0 = pn * BM + wc * 32 + 8 * fq;
#pragma unroll
        for (int ai = 0; ai < 2; ++ai)
#pragma unroll
            for (int m = 0; m < 4; ++m) { bf16_t* rowp = O + (size_t)(row0 + ai * HALF + m * 16) * ldc + col0;
#pragma unroll
                for (int bj = 0; bj < 2; ++bj) { const f32x4 v0 = acc[ai][bj][m][0] * (1.0f / 64.0f), v1 = acc[ai][bj][m][1] * (1.0f / 64.0f);
                    u32x4 w; w.x = cvt_pk_bf16(v0[0], v0[1]); w.y = cvt_pk_bf16(v0[2], v0[3]); w.z = cvt_pk_bf16(v1[0], v1[1]); w.w = cvt_pk_bf16(v1[2], v1[3]);
                    *(u32x4*)(rowp + bj * HALF) = w; } }
    }
};
struct EpiResBf16Ssq {
    static constexpr bool PERM = true, ADJ = false, AFTER_DRAIN = false, NEEDS_NOP = false;
    const float* invr; const float* invg; bf16_t* O; float* ssq; unsigned char* O8;
    __device__ __forceinline__ void operator()(const f32x4 (&acc)[2][2][4][2], const Unit& u, int wr, int wc, int fr, int fq) const {
        typedef unsigned u32x2 __attribute__((ext_vector_type(2)));
        const int row0 = u.pm * BM + wr * 64 + fr, col0 = u.pn * BM + wc * 32 + 8 * fq;
        f32x4 ig[2][2];
#pragma unroll
        for (int bj = 0; bj < 2; ++bj) { ig[bj][0] = *(const f32x4*)(invg + col0 + bj * HALF); ig[bj][1] = *(const f32x4*)(invg + col0 + bj * HALF + 4); }
#pragma unroll
        for (int ai = 0; ai < 2; ++ai) {
            u32x4 abv[4][2]; float irv[4];
#pragma unroll
            for (int m = 0; m < 4; ++m) { const int row = row0 + ai * HALF + m * 16; irv[m] = invr[row];
#pragma unroll
                for (int bj = 0; bj < 2; ++bj) abv[m][bj] = *(const u32x4*)(O + (size_t)row * 1024 + col0 + bj * HALF); }
            __builtin_amdgcn_sched_barrier(0);
#pragma unroll
            for (int m = 0; m < 4; ++m) { const int row = row0 + ai * HALF + m * 16; const size_t off = (size_t)row * 1024 + col0; const float ir = irv[m]; float s = 0.f;
#pragma unroll
                for (int bj = 0; bj < 2; ++bj) { const u32x4 ab = abv[m][bj];
                    const f32x4 x0 = {__uint_as_float(ab.x << 16), __uint_as_float(ab.x & 0xffff0000u), __uint_as_float(ab.y << 16), __uint_as_float(ab.y & 0xffff0000u)};
                    const f32x4 x1 = {__uint_as_float(ab.z << 16), __uint_as_float(ab.z & 0xffff0000u), __uint_as_float(ab.w << 16), __uint_as_float(ab.w & 0xffff0000u)};
                    const f32x4 v0 = acc[ai][bj][m][0] + x0 * ig[bj][0] * ir, v1 = acc[ai][bj][m][1] + x1 * ig[bj][1] * ir;
                    s += (v0[0] * v0[0] + v0[1] * v0[1]) + (v0[2] * v0[2] + v0[3] * v0[3]) + (v1[0] * v1[0] + v1[1] * v1[1]) + (v1[2] * v1[2] + v1[3] * v1[3]);
                    u32x4 w; w.x = cvt_pk_bf16(v0[0], v0[1]); w.y = cvt_pk_bf16(v0[2], v0[3]); w.z = cvt_pk_bf16(v1[0], v1[1]); w.w = cvt_pk_bf16(v1[2], v1[3]);
                    *(u32x4*)(O + off + bj * HALF) = w;
                    u32x2 w8; w8.x = cvt4_fp8(v0[0], v0[1], v0[2], v0[3]); w8.y = cvt4_fp8(v1[0], v1[1], v1[2], v1[3]); *(u32x2*)(O8 + off + bj * HALF) = w8; }
                s += __shfl_xor(s, 16); s += __shfl_xor(s, 32);
                if (fq == 0) ssq[(size_t)row * 16 + u.pn * 4 + wc] = s; }
        }
    }
};
struct EpiBf16RowScale {
    static constexpr bool PERM = true, ADJ = false, AFTER_DRAIN = false, NEEDS_NOP = false;
    bf16_t* O; const float* ssq; int ldc; float eps; float wscale; int pad;
    __device__ __forceinline__ void operator()(const f32x4 (&acc)[2][2][4][2], const Unit& u, int wr, int wc, int fr, int fq) const {
        const int row0 = u.pm * BM + wr * 64 + fr, col0 = u.pn * BM + wc * 32 + 8 * fq;
        float sv[2][4];
#pragma unroll
        for (int ai = 0; ai < 2; ++ai)
#pragma unroll
            for (int mp = 0; mp < 4; mp += 2) { f32x4 pv[2][4];
#pragma unroll
                for (int q = 0; q < 2; ++q) { const f32x4* sp = (const f32x4*)(ssq + (size_t)(row0 + ai * HALF + (mp + q) * 16) * 16);
#pragma unroll
                    for (int k = 0; k < 4; ++k) pv[q][k] = sp[k]; }
                __builtin_amdgcn_sched_barrier(0);
#pragma unroll
                for (int q = 0; q < 2; ++q) { const f32x4 p0 = pv[q][0], p1 = pv[q][1], p2 = pv[q][2], p3 = pv[q][3];
                    const float tot = (((p0[0] + p0[1]) + (p0[2] + p0[3])) + ((p1[0] + p1[1]) + (p1[2] + p1[3]))) + (((p2[0] + p2[1]) + (p2[2] + p2[3])) + ((p3[0] + p3[1]) + (p3[2] + p3[3])));
                    sv[ai][mp + q] = __builtin_amdgcn_rsqf(tot * (1.0f / 1024.0f) + eps) * wscale; } }
#pragma unroll
        for (int ai = 0; ai < 2; ++ai)
#pragma unroll
            for (int m = 0; m < 4; ++m) { const int row = row0 + ai * HALF + m * 16;
                const float s = sv[ai][m]; bf16_t* rowp = O + (size_t)row * ldc + col0;
#pragma unroll
                for (int bj = 0; bj < 2; ++bj) { const f32x4 v0 = acc[ai][bj][m][0] * s, v1 = acc[ai][bj][m][1] * s;
                    u32x4 w; w.x = cvt_pk_bf16(v0[0], v0[1]); w.y = cvt_pk_bf16(v0[2], v0[3]); w.z = cvt_pk_bf16(v1[0], v1[1]); w.w = cvt_pk_bf16(v1[2], v1[3]);
                    *(u32x4*)(rowp + bj * HALF) = w; } }
    }
};
struct EpiResBf16ToF32 {
    static constexpr bool PERM = false, ADJ = false, AFTER_DRAIN = false, NEEDS_NOP = false;
    const bf16_t* Rb; float* C; float wscale; int pad;
    __device__ __forceinline__ void operator()(const f32x4 (&acc)[2][2][4][2], const Unit& u, int wr, int wc, int fr, int fq) const {
        typedef unsigned u32x2 __attribute__((ext_vector_type(2)));
        const int row0 = u.pm * BM + wr * 64 + fr, col0 = u.pn * BM + wc * 32 + 4 * fq;
#pragma unroll
        for (int ai = 0; ai < 2; ++ai)
#pragma unroll
            for (int m = 0; m < 4; ++m) { const size_t off = (size_t)(row0 + ai * HALF + m * 16) * 1024 + col0;
#pragma unroll
                for (int bj = 0; bj < 2; ++bj)
#pragma unroll
                    for (int n = 0; n < 2; ++n) { const u32x2 rb = *(const u32x2*)(Rb + off + bj * HALF + n * 16);
                        const f32x4 r = {__uint_as_float(rb.x << 16), __uint_as_float(rb.x & 0xffff0000u), __uint_as_float(rb.y << 16), __uint_as_float(rb.y & 0xffff0000u)};
                        *(f32x4*)(C + off + bj * HALF + n * 16) = r + acc[ai][bj][m][n] * wscale; } }
    }
};
struct EpiResBf16InPlace {
    static constexpr bool PERM = true, ADJ = false, AFTER_DRAIN = false, NEEDS_NOP = false;
    const bf16_t* Rb; bf16_t* Ob; unsigned char* X8; const float* gain; float* ssq; float wscale; int pad;
    __device__ __forceinline__ void operator()(const f32x4 (&acc)[2][2][4][2], const Unit& u, int wr, int wc, int fr, int fq) const {
        typedef unsigned u32x2 __attribute__((ext_vector_type(2)));
        const int row0 = u.pm * BM + wr * 64 + fr, col0 = u.pn * BM + wc * 32 + 8 * fq;
        f32x4 gn[2][2];
#pragma unroll
        for (int bj = 0; bj < 2; ++bj) { gn[bj][0] = *(const f32x4*)(gain + col0 + bj * HALF); gn[bj][1] = *(const f32x4*)(gain + col0 + bj * HALF + 4); }
#pragma unroll
        for (int ai = 0; ai < 2; ++ai) {
            u32x4 rbv[4][2];
#pragma unroll
            for (int m = 0; m < 4; ++m)
#pragma unroll
                for (int bj = 0; bj < 2; ++bj) rbv[m][bj] = *(const u32x4*)(Rb + (size_t)(row0 + ai * HALF + m * 16) * 1024 + col0 + bj * HALF);
            __builtin_amdgcn_sched_barrier(0);
#pragma unroll
            for (int m = 0; m < 4; ++m) { const int row = row0 + ai * HALF + m * 16; const size_t off = (size_t)row * 1024 + col0; float s = 0.f;
#pragma unroll
                for (int bj = 0; bj < 2; ++bj) { const u32x4 rb = rbv[m][bj];
                    const f32x4 v0 = acc[ai][bj][m][0] * wscale + (f32x4){__uint_as_float(rb.x << 16), __uint_as_float(rb.x & 0xffff0000u), __uint_as_float(rb.y << 16), __uint_as_float(rb.y & 0xffff0000u)};
                    const f32x4 v1 = acc[ai][bj][m][1] * wscale + (f32x4){__uint_as_float(rb.z << 16), __uint_as_float(rb.z & 0xffff0000u), __uint_as_float(rb.w << 16), __uint_as_float(rb.w & 0xffff0000u)};
                    s += (v0[0] * v0[0] + v0[1] * v0[1]) + (v0[2] * v0[2] + v0[3] * v0[3]) + (v1[0] * v1[0] + v1[1] * v1[1]) + (v1[2] * v1[2] + v1[3] * v1[3]);
                    u32x4 w; w.x = cvt_pk_bf16(v0[0], v0[1]); w.y = cvt_pk_bf16(v0[2], v0[3]); w.z = cvt_pk_bf16(v1[0], v1[1]); w.w = cvt_pk_bf16(v1[2], v1[3]);
                    *(u32x4*)(Ob + off + bj * HALF) = w;
                    const f32x4 g0 = v0 * gn[bj][0], g1 = v1 * gn[bj][1];
                    u32x2 w8; w8.x = cvt4_fp8(g0[0], g0[1], g0[2], g0[3]); w8.y = cvt4_fp8(g1[0], g1[1], g1[2], g1[3]); *(u32x2*)(X8 + off + bj * HALF) = w8; }
                s += __shfl_xor(s, 16); s += __shfl_xor(s, 32);
                if (fq == 0) ssq[(size_t)row * 16 + u.pn * 4 + wc] = s; }
        }
    }
};
struct EpiMoe1 {
    static constexpr bool PERM = true, ADJ = false, AFTER_DRAIN = false, NEEDS_NOP = false;
    bf16_t* H; const float* rsl;
    __device__ __forceinline__ void operator()(const f32x4 (&acc)[2][2][4][2], const Unit& u, int wr, int wc, int fr, int fq) const {
        const int row0 = u.pm * BM + wr * 64 + fr, col0 = (u.pn & 3) * 128 + wc * 32 + 8 * fq;
#pragma unroll
        for (int ai = 0; ai < 2; ++ai)
#pragma unroll
            for (int m = 0; m < 4; ++m) { const int row = row0 + ai * HALF + m * 16; const float sc = rsl[row]; bf16_t* rowp = H + (size_t)row * 512 + col0;
                const f32x4 g0 = acc[ai][0][m][0] * sc, g1 = acc[ai][0][m][1] * sc, u0 = acc[ai][1][m][0] * sc, u1 = acc[ai][1][m][1] * sc;
                u32x4 w; w.x = cvt_pk_bf16(fast_silu(g0[0]) * u0[0], fast_silu(g0[1]) * u0[1]); w.y = cvt_pk_bf16(fast_silu(g0[2]) * u0[2], fast_silu(g0[3]) * u0[3]);
                w.z = cvt_pk_bf16(fast_silu(g1[0]) * u1[0], fast_silu(g1[1]) * u1[1]); w.w = cvt_pk_bf16(fast_silu(g1[2]) * u1[2], fast_silu(g1[3]) * u1[3]);
                *(u32x4*)rowp = w; }
    }
};
struct EpiMoe1F8 {
    static constexpr bool PERM = true, ADJ = false, AFTER_DRAIN = false, NEEDS_NOP = false;
    unsigned char* H; const float* rsl;
    __device__ __forceinline__ void operator()(const f32x4 (&acc)[2][2][4][2], const Unit& u, int wr, int wc, int fr, int fq) const {
        typedef unsigned u32x2 __attribute__((ext_vector_type(2)));
        const int row0 = u.pm * BM + wr * 64 + fr, col0 = (u.pn & 3) * 128 + wc * 32 + 8 * fq;
        float scv[2][4];
#pragma unroll
        for (int ai = 0; ai < 2; ++ai)
#pragma unroll
            for (int m = 0; m < 4; ++m) scv[ai][m] = rsl[row0 + ai * HALF + m * 16];
        __builtin_amdgcn_sched_barrier(0);
#pragma unroll
        for (int ai = 0; ai < 2; ++ai)
#pragma unroll
            for (int m = 0; m < 4; ++m) { const int row = row0 + ai * HALF + m * 16; const float sc = scv[ai][m] * (1.0f / 64.0f);
                const f32x4 g0 = acc[ai][0][m][0] * sc, g1 = acc[ai][0][m][1] * sc, u0 = acc[ai][1][m][0] * sc, u1 = acc[ai][1][m][1] * sc;
                u32x2 w; w.x = cvt4_fp8(fast_silu(g0[0]) * u0[0], fast_silu(g0[1]) * u0[1], fast_silu(g0[2]) * u0[2], fast_silu(g0[3]) * u0[3]);
                w.y = cvt4_fp8(fast_silu(g1[0]) * u1[0], fast_silu(g1[1]) * u1[1], fast_silu(g1[2]) * u1[2], fast_silu(g1[3]) * u1[3]);
                *(u32x2*)(H + (size_t)row * 512 + col0) = w; }
    }
};
struct EpiMoe2 {
    static constexpr bool PERM = true, ADJ = false, AFTER_DRAIN = false, NEEDS_NOP = false;
    unsigned char* Yb; const float* gate; float wscale; int pad;
    __device__ __forceinline__ void operator()(const f32x4 (&acc)[2][2][4][2], const Unit& u, int wr, int wc, int fr, int fq) const {
        typedef unsigned u32x2 __attribute__((ext_vector_type(2)));
        const int row0 = u.pm * BM + wr * 64 + fr, col0 = (u.pn & 3) * BM + wc * 32 + 8 * fq;
        float gtv[2][4];
#pragma unroll
        for (int ai = 0; ai < 2; ++ai)
#pragma unroll
            for (int m = 0; m < 4; ++m) gtv[ai][m] = gate[row0 + ai * HALF + m * 16];
        __builtin_amdgcn_sched_barrier(0);
#pragma unroll
        for (int ai = 0; ai < 2; ++ai)
#pragma unroll
            for (int m = 0; m < 4; ++m) { const int row = row0 + ai * HALF + m * 16; const float s = gtv[ai][m] * wscale * 16.0f; unsigned char* rowp = Yb + (size_t)row * 1024 + col0;
#pragma unroll
                for (int bj = 0; bj < 2; ++bj) { const f32x4 v0 = acc[ai][bj][m][0] * s, v1 = acc[ai][bj][m][1] * s;
                    u32x2 w; w.x = cvt4_fp8(v0[0], v0[1], v0[2], v0[3]); w.y = cvt4_fp8(v1[0], v1[1], v1[2], v1[3]);
                    *(u32x2*)(rowp + bj * HALF) = w; } }
    }
};

template <class Epi, class Sched, bool ALIGN_EPI, bool GATHER, bool FP8 = false>
__device__ __forceinline__ void gemm_phase(PG8_LAS unsigned char* lds, const Gemm g, const Sched& S, const Epi& E) {
    const int tid = threadIdx.x, wid = __builtin_amdgcn_readfirstlane(tid >> 6), lane = tid & 63, wr = wid >> 2, wc = wid & 3, fr = lane & 15, fq = lane >> 4;
    const int K = g.K, Kb = FP8 ? K : 2 * K  , nt = Kb / 128;
    unsigned voffA[2], voffB[2];
#pragma unroll
    for (int i = 0; i < 2; ++i) { int R, C; stage_rc(tid * 16 + i * 8192, R, C); const int Rb = Epi::PERM ? ((R & ~31) + perm32(R & 31)) : R;
        const int Rb2 = Epi::ADJ ? ((R >> 5) * 64 + perm32(R & 31)) : Rb;
        voffA[i] = (unsigned)(R * Kb + 2 * C); voffB[i] = (unsigned)(Rb2 * Kb + 2 * C); }
    const size_t kstep = 128;
    const size_t hstep = (size_t)HALF * Kb;
    const size_t tstep = 2 * hstep;
    const size_t hsA = GATHER ? 0 : hstep;
    const size_t hsB = Epi::ADJ ? (size_t)32 * Kb : hstep;
    const unsigned ldsw = (unsigned)wid * 1024u;
    const int aoff = lds_byte(wr * 64 + fr, FP8 ? fq * 16 : fq * 8), boff = lds_byte(wc * 32 + fr, FP8 ? fq * 16 : fq * 8);
#define PG8_SA(b, h) (((b) * 2 + (h)) * HTB)
#define PG8_SB(b, h) ((4 + (b) * 2 + (h)) * HTB)
#define PG8_STAGE(bufoff, gbase, voff) do { _Pragma("unroll") for (int _i = 0; _i < 2; ++_i) \
        __builtin_amdgcn_global_load_lds((const unsigned*)((const char*)(gbase) + (voff)[_i]), (PG8_LAS unsigned*)(lds + (bufoff) + ldsw + _i * 8192), 16, 0, 0); } while (0)
#define PG8_LDF(dst, off_) do { if constexpr (FP8) { const i32x4_ lo_ = *(const PG8_LAS i32x4_*)(lds + (off_)), hi_ = *(const PG8_LAS i32x4_*)(lds + (off_) + 16); dst = __builtin_shufflevector(lo_, hi_, 0, 1, 2, 3, 4, 5, 6, 7); } \
        else { dst[0] = *(const PG8_LAS bf16x8*)(lds + (off_)); dst[1] = *(const PG8_LAS bf16x8*)(lds + (off_) + 1024); } } while (0)
#define PG8_LDA(dst, b, h) do { _Pragma("unroll") for (int m = 0; m < 4; ++m) PG8_LDF(dst[m], PG8_SA(b, h) + aoff + m * 2048); } while (0)
#define PG8_LDB(dst, b, h) do { _Pragma("unroll") for (int n = 0; n < 2; ++n) PG8_LDF(dst[n], PG8_SB(b, h) + boff + n * 2048); } while (0)
#define PG8_MMA(ai, bj, At, Bt) do { __builtin_amdgcn_s_setprio(1); _Pragma("unroll") for (int m = 0; m < 4; ++m) _Pragma("unroll") for (int n = 0; n < 2; ++n) { \
        if constexpr (FP8) asm volatile("v_mfma_scale_f32_16x16x128_f8f6f4 %0, %1, %2, %0, %3, %3 op_sel_hi:[0,0,0]" : "+v"(acc[ai][bj][m][n]) : "v"(Bt[n]), "v"(At[m]), "v"(sc1_));     \
        else { _Pragma("unroll") for (int k = 0; k < 2; ++k) acc[ai][bj][m][n] = __builtin_amdgcn_mfma_f32_16x16x32_bf16(Bt[n][k], At[m][k], acc[ai][bj][m][n], 0, 0, 0); } } __builtin_amdgcn_s_setprio(0); } while (0)
#define PG8_WAIT_V(n) asm volatile("s_waitcnt vmcnt(" #n ")" ::: "memory")
#define PG8_WAIT_L(n) asm volatile("s_waitcnt lgkmcnt(" #n ")" ::: "memory")
#define PG8_BAR __builtin_amdgcn_s_barrier()
#define PG8_SCHED __builtin_amdgcn_sched_barrier(0)
    unsigned vc0[2], vc1[2], vn0[2], vn1[2];
#define PG8_LOADIDX(v0, v1, pm_) do { _Pragma("unroll") for (int _i = 0; _i < 2; ++_i) { int R_, C_; stage_rc(tid * 16 + _i * 8192, R_, C_); \
        v0[_i] = (unsigned)g.gidx[(pm_) * BM + R_] * (unsigned)Kb + 2u * (unsigned)C_; v1[_i] = (unsigned)g.gidx[(pm_) * BM + HALF + R_] * (unsigned)Kb + 2u * (unsigned)C_; } } while (0)
    Unit cur, nxt; int ui = 0;
    if (!S.next(0, cur)) return;
    f32x4 acc[2][2][4][2];
#pragma unroll
    for (int a = 0; a < 2; ++a)
#pragma unroll
        for (int b = 0; b < 2; ++b)
#pragma unroll
            for (int m = 0; m < 4; ++m)
#pragma unroll
                for (int n = 0; n < 2; ++n) acc[a][b][m][n] = (f32x4){0.f, 0.f, 0.f, 0.f};
    typedef int i32x4_ __attribute__((ext_vector_type(4))); typedef int i32x8_ __attribute__((ext_vector_type(8)));
    struct FragB { bf16x8 k[2]; __device__ __forceinline__ bf16x8& operator[](int i) { return k[i]; } };
    typedef typename std::conditional<FP8, i32x8_, FragB>::type frag_t;
    frag_t At[4], B0[2], B1[2];
    const int sc1_ = 0x7f7f7f7f;
    if constexpr (GATHER) { PG8_LOADIDX(vc0, vc1, cur.pm); } else {
#pragma unroll
        for (int i = 0; i < 2; ++i) { vc0[i] = voffA[i]; vc1[i] = voffA[i]; } }
    const char* cA = GATHER ? (const char*)g.A : (const char*)g.A + (size_t)cur.pm * tstep; const char* cB = (const char*)g.Bt + (size_t)cur.pn * tstep;
    S.a_ready(cur);
    PG8_STAGE(PG8_SB(0, 0), cB, voffB); PG8_STAGE(PG8_SB(0, 1), cB + hsB, voffB); PG8_STAGE(PG8_SA(0, 0), cA, vc0); PG8_STAGE(PG8_SA(0, 1), cA + hsA, vc1);
    if (wr == 1) PG8_BAR;
    PG8_WAIT_V(2); PG8_BAR;
    PG8_STAGE(PG8_SB(1, 0), cB + kstep, voffB); PG8_STAGE(PG8_SA(1, 0), cA + kstep, vc0); PG8_STAGE(PG8_SB(1, 1), cB + hsB + kstep, voffB);
    PG8_WAIT_V(6); PG8_BAR;
    for (;;) {
        const bool has_next = S.next(ui + 1, nxt);
        const char* nA = GATHER ? cA : (has_next ? (const char*)g.A + (size_t)nxt.pm * tstep : cA); const char* nB = has_next ? (const char*)g.Bt + (size_t)nxt.pn * tstep : cB;
        if constexpr (GATHER) { if (has_next) { PG8_LOADIDX(vn0, vn1, nxt.pm); } else {
#pragma unroll
            for (int i = 0; i < 2; ++i) { vn0[i] = vc0[i]; vn1[i] = vc1[i]; } } }
#pragma unroll 1
        for (int t = 0; t < nt; t += 2) {
            const bool last = (t == nt - 2);
            const char* a1 = cA + (size_t)(t + 1) * kstep;
            const char* a2 = last ? nA : cA + (size_t)(t + 2) * kstep; const char* b2 = last ? nB : cB + (size_t)(t + 2) * kstep;
            const char* a3 = a2 + kstep; const char* b3 = b2 + kstep;
            unsigned w0[2], w1[2];
#pragma unroll
            for (int i = 0; i < 2; ++i) { w0[i] = (GATHER && last) ? vn0[i] : vc0[i]; w1[i] = (GATHER && last) ? vn1[i] : vc1[i]; }
            if (last && has_next) S.a_ready(nxt);
            PG8_LDB(B0, 0, 0); PG8_LDB(B1, 0, 1); PG8_SCHED; PG8_LDA(At, 0, 0); PG8_STAGE(PG8_SA(1, 1), a1 + hsA, vc1);
            PG8_WAIT_V(8); PG8_WAIT_L(0); PG8_BAR; PG8_MMA(0, 0, At, B0); PG8_MMA(0, 1, At, B1); PG8_BAR; PG8_SCHED;
            PG8_LDA(At, 0, 1); PG8_STAGE(PG8_SB(0, 0), b2, voffB); PG8_STAGE(PG8_SB(0, 1), b2 + hsB, voffB); PG8_STAGE(PG8_SA(0, 0), a2, w0);
            PG8_WAIT_V(8); PG8_WAIT_L(0); PG8_BAR; PG8_MMA(1, 0, At, B0); PG8_MMA(1, 1, At, B1); PG8_BAR; PG8_SCHED;
            PG8_LDB(B0, 1, 0); PG8_LDB(B1, 1, 1); PG8_SCHED; PG8_LDA(At, 1, 0); PG8_STAGE(PG8_SA(0, 1), a2 + hsA, w1);
            PG8_WAIT_V(8); PG8_WAIT_L(0); PG8_BAR; PG8_MMA(0, 0, At, B0); PG8_MMA(0, 1, At, B1); PG8_BAR; PG8_SCHED;
            PG8_LDA(At, 1, 1); PG8_STAGE(PG8_SB(1, 0), b3, voffB); PG8_STAGE(PG8_SB(1, 1), b3 + hsB, voffB); PG8_STAGE(PG8_SA(1, 0), a3, w0);
            PG8_WAIT_V(8); PG8_WAIT_L(0); PG8_BAR; PG8_MMA(1, 0, At, B0); PG8_MMA(1, 1, At, B1); PG8_BAR; PG8_SCHED;
        }
        if constexpr (ALIGN_EPI) { if (wr == 0) PG8_BAR; }
        if constexpr (FP8 || Epi::NEEDS_NOP) asm volatile("s_nop 15\n\ts_nop 15" ::: "memory");
        if constexpr (Epi::ADJ) E(acc, cur, wr, wc, fr, fq, lds + STAGE_BYTES + wid * 2048); else E(acc, cur, wr, wc, fr, fq);
        S.done(cur);
        if (!has_next) break;
#pragma unroll
        for (int a = 0; a < 2; ++a)
#pragma unroll
            for (int b = 0; b < 2; ++b)
#pragma unroll
                for (int m = 0; m < 4; ++m)
#pragma unroll
                    for (int n = 0; n < 2; ++n) acc[a][b][m][n] = (f32x4){0.f, 0.f, 0.f, 0.f};
        cur = nxt; cA = nA; cB = nB; ++ui;
        if constexpr (GATHER) {
#pragma unroll
            for (int i = 0; i < 2; ++i) { vc0[i] = vn0[i]; vc1[i] = vn1[i]; } }
        if constexpr (ALIGN_EPI) { if (wr == 1) PG8_BAR; }
    }
    PG8_WAIT_V(0);
    if constexpr (!ALIGN_EPI) { if (wr == 0) PG8_BAR; }
    PG8_BAR;
#undef PG8_SA
#undef PG8_SB
#undef PG8_STAGE
#undef PG8_LDA
#undef PG8_LDF
#undef PG8_LDB
#undef PG8_MMA
#undef PG8_WAIT_V
#undef PG8_WAIT_L
#undef PG8_BAR
#undef PG8_SCHED
#undef PG8_LOADIDX
}
}
#define GAS __attribute__((address_space(1)))
#define LAS __attribute__((address_space(3)))
typedef unsigned v4u __attribute__((ext_vector_type(4)));
typedef float f32x4 __attribute__((ext_vector_type(4)));
typedef float f32x2v __attribute__((ext_vector_type(2)));
#define LDS_WAIT() asm volatile("s_waitcnt lgkmcnt(0)" ::: "memory")
#define VM_WAIT() asm volatile("s_waitcnt vmcnt(0)" ::: "memory")
constexpr int NWAVES = 8;
#ifndef TAIL_GATE
#define TAIL_GATE 1
#endif
#ifndef WGM_P1
#define WGM_P1 4
#endif
#ifndef WGM_N1K
#define WGM_N1K 4
#endif
#ifndef WGM_MOE
#define WGM_MOE 4
#endif
constexpr int RING_OFF = 0, RING_BYTES = 131072;
constexpr int LDSCTL_OFF = 163840 - 1024, MISC_OFF = LDSCTL_OFF + 320;
constexpr int LDS_BYTES = 163840;
constexpr int CW_BAR = 4096;
constexpr size_t CTL_ZERO_BYTES = 64 * 1024;

__device__ __forceinline__ unsigned pk2(float lo, float hi) { return (unsigned)f2bf(lo) | ((unsigned)f2bf(hi) << 16); }

#define XB_TMO      128
#define XB_XCNT(j)  (256  + 64 * (j))
#define XB_XSUB(j)  (1280 + 64 * (j))
#define XB_XGEN(j)  (2304 + 64 * (j))
#define XB_TOP      3328
#define XB_TOPGEN   3392
#define XCD_BAR_WORDS 3456
#define XB_SPIN_CAP (1u << 18)

__device__ __forceinline__ unsigned xb_ld(unsigned* p)              { return __hip_atomic_load(p, __ATOMIC_RELAXED, __HIP_MEMORY_SCOPE_AGENT); }
__device__ __forceinline__ unsigned xb_add(unsigned* p, unsigned v) { return __hip_atomic_fetch_add(p, v, __ATOMIC_RELAXED, __HIP_MEMORY_SCOPE_AGENT); }
__device__ __forceinline__ unsigned xb_xcc_id() { return (unsigned)__builtin_amdgcn_s_getreg((3 << 11) | 20) & 0xFu; }
#define XB_SPIN(cond, bar) do { unsigned _sp = 0; while (cond) { __builtin_amdgcn_s_sleep(1); \
    if ((++_sp & 255u) == 0u) { if (xb_ld(&(bar)[XB_TMO])) break; if (_sp > XB_SPIN_CAP) { atomicAdd(&(bar)[XB_TMO], 1u); break; } } } } while (0)

struct XcdBarrier {
    unsigned* bar; unsigned x;
    volatile LAS unsigned* st;
};
__device__ __forceinline__ XcdBarrier xcd_barrier_post(unsigned* bar, volatile LAS unsigned* st) {
    XcdBarrier b; b.bar = bar; b.x = xb_xcc_id(); b.st = st;
    if (threadIdx.x == 0) (void)xb_add(&bar[XB_XCNT(b.x)], 1u);
    return b;
}
__device__ __forceinline__ void xcd_barrier_complete(unsigned* bar, unsigned x, unsigned& nloc, unsigned& nx) {
    const unsigned G = gridDim.x * gridDim.y * gridDim.z;
    unsigned sum, cnt, mine, sp = 0u;
    for (;;) {
        sum = 0u; cnt = 0u; mine = 0u;
#pragma unroll
        for (unsigned j = 0; j < 16; ++j) { const unsigned c = xb_ld(&bar[XB_XCNT(j)]); sum += c; cnt += (c > 0u) ? 1u : 0u; mine = (j == x) ? c : mine; }
        if (sum == G) break;
        __builtin_amdgcn_s_sleep(1);
        if ((++sp & 255u) == 0u) { if (xb_ld(&bar[XB_TMO])) break; if (sp > XB_SPIN_CAP) { atomicAdd(&bar[XB_TMO], 1u); break; } }
    }
    nloc = mine > 0u ? mine : 1u; nx = cnt > 0u ? cnt : 1u;
}
__device__ __forceinline__ void xcd_barrier(const XcdBarrier& b) {
    asm volatile("s_waitcnt vmcnt(0)" ::: "memory");
    __syncthreads();
    if (threadIdx.x == 0) {
        unsigned* bar = b.bar;
        __builtin_amdgcn_s_waitcnt(0);
        unsigned nloc = b.st[0], nx = b.st[1];
        if (nloc == 0u) { xcd_barrier_complete(bar, b.x, nloc, nx); b.st[0] = nloc; b.st[1] = nx; }
        const unsigned old = xb_add(&bar[XB_XSUB(b.x)], 1u);
        const unsigned gen = old / nloc;
        if (old + 1u == (gen + 1u) * nloc) {
            __builtin_amdgcn_fence(__ATOMIC_RELEASE, "agent");
            asm volatile("s_waitcnt vmcnt(0)" ::: "memory");
            const unsigned og = xb_add(&bar[XB_TOP], 1u);
            const unsigned tg = og / nx;
            if (og + 1u == (tg + 1u) * nx) xb_add(&bar[XB_TOPGEN], 1u);
            else XB_SPIN(xb_ld(&bar[XB_TOPGEN]) == tg, bar);
            __builtin_amdgcn_fence(__ATOMIC_ACQUIRE, "agent");
            xb_add(&bar[XB_XGEN(b.x)], 1u);
            asm volatile("s_waitcnt vmcnt(0)" ::: "memory");
        } else {
            XB_SPIN(xb_ld(&bar[XB_XGEN(b.x)]) == gen, bar);
            __builtin_amdgcn_fence(__ATOMIC_ACQUIRE, "agent");
            asm volatile("s_waitcnt vmcnt(0)" ::: "memory");
        }
    }
    __syncthreads();
}

__device__ __forceinline__ void p0_transpose_item(const float* W, int K, int N, bf16* WT, int row_off, LAS float* scr, int kb, int nb, int lane, const float* gk = nullptr) {
    const int k0 = 64 * kb, n0 = 32 * nb;
#pragma unroll
    for (int i = 0; i < 32; ++i) { const int kk = 2 * i + (lane >> 5); scr[kk * 33 + (lane & 31)] = W[(size_t)(k0 + kk) * N + n0 + (lane & 31)] * (gk ? gk[k0 + kk] : 1.0f); }
    LDS_WAIT(); asm volatile("" ::: "memory");
    const int c = lane & 7;
#pragma unroll
    for (int j = 0; j < 4; ++j) { const int n = (lane >> 3) + 8 * j; const LAS float* s = scr + (8 * c) * 33 + n;
        v4u o; o.x = pk2(s[0 * 33], s[1 * 33]); o.y = pk2(s[2 * 33], s[3 * 33]); o.z = pk2(s[4 * 33], s[5 * 33]); o.w = pk2(s[6 * 33], s[7 * 33]);
        *(GAS v4u*)(WT + (size_t)(row_off + n0 + n) * K + k0 + 8 * c) = o; }
    LDS_WAIT(); asm volatile("" ::: "memory");
}
__device__ __forceinline__ void p0_transpose_item8(const float* W, int K, int N, unsigned char* WT, int row_off, LAS float* scr, int kb, int nb, int lane, float scale, const float* gk = nullptr) {
    typedef unsigned v2u_ __attribute__((ext_vector_type(2)));
    const int k0 = 64 * kb, n0 = 32 * nb;
    float wv[32];
#pragma unroll
    for (int i = 0; i < 32; ++i) { const int kk = 2 * i + (lane >> 5); wv[i] = W[(size_t)(k0 + kk) * N + n0 + (lane & 31)]; }
    if (gk) {
#pragma unroll
        for (int i = 0; i < 32; ++i) wv[i] *= gk[k0 + 2 * i + (lane >> 5)]; }
#pragma unroll
    for (int i = 0; i < 32; ++i) { const int kk = 2 * i + (lane >> 5); scr[kk * 33 + (lane & 31)] = wv[i] * scale; }
    LDS_WAIT(); asm volatile("" ::: "memory");
    const int c = lane & 7;
#pragma unroll
    for (int j = 0; j < 4; ++j) { const int n = (lane >> 3) + 8 * j; const LAS float* sp = scr + (8 * c) * 33 + n;
        v2u_ o; o.x = pg8::cvt4_fp8(sp[0 * 33], sp[1 * 33], sp[2 * 33], sp[3 * 33]); o.y = pg8::cvt4_fp8(sp[4 * 33], sp[5 * 33], sp[6 * 33], sp[7 * 33]);
        *(GAS v2u_*)(WT + (size_t)(row_off + n0 + n) * K + k0 + 8 * c) = o; }
    LDS_WAIT(); asm volatile("" ::: "memory");
}
__device__ __forceinline__ void rms_row_to_bf16(const float* xrow, const float* gain, bf16* orow, int lane) {
    const GAS f32x4* xr = (const GAS f32x4*)xrow + lane;
    f32x4 v[4]; float s = 0.f;
#pragma unroll
    for (int j = 0; j < 4; ++j) { v[j] = xr[64 * j]; s += (v[j].x * v[j].x + v[j].y * v[j].y) + (v[j].z * v[j].z + v[j].w * v[j].w); }
    const float r = 1.0f / sqrtf(wave_sum(s) * (1.f / 1024.f) + EPS);
    GAS unsigned long long* o8 = (GAS unsigned long long*)orow + lane;
#pragma unroll
    for (int j = 0; j < 4; ++j) { const f32x4 g = ((const GAS f32x4*)gain)[lane + 64 * j];
        o8[64 * j] = (unsigned long long)pk2(v[j].x * r * g.x, v[j].y * r * g.y) | ((unsigned long long)pk2(v[j].z * r * g.z, v[j].w * r * g.w) << 32); }
}

__device__ __forceinline__ void attn_phase(LAS unsigned char* lds, const bf16* Q, const bf16* KB, const bf16* VT, unsigned char* O, int G) {
    typedef short bf16x8 __attribute__((ext_vector_type(8)));
    typedef short bf16x4 __attribute__((ext_vector_type(4)));
    typedef float f32x16 __attribute__((ext_vector_type(16)));
    typedef unsigned v2u __attribute__((ext_vector_type(2)));
    const int tid = threadIdx.x, lane = tid & 63, wave = __builtin_amdgcn_readfirstlane(tid >> 6), r32 = lane & 31, hh = lane >> 5;
    constexpr int BUFB = 32768, OP = 272;
    unsigned koff[4], voff[4];
#pragma unroll
    for (int i4 = 0; i4 < 4; ++i4) { const int p_ = wave * 4 + i4;
        { const int r_ = 2 * p_ + (lane >> 5), cg_ = (lane & 31) ^ (r_ & 31); koff[i4] = (unsigned)(r_ * 1024 + cg_ * 8) * 2u; }
        { const int r_ = 8 * p_ + (lane >> 3), cg_ = (lane & 7) ^ ((r_ >> 1) & 7); voff[i4] = (unsigned)(r_ * 8192 + cg_ * 8) * 2u; } }
    for (int i = 0;; ++i) {
        const int L = i * G + (int)blockIdx.x; if (L >= 1024) break;
        const int v = (G == 256) ? ((int)blockIdx.x & 7) * 128 + i * 32 + ((int)blockIdx.x >> 3) : L;
        const int qt = v & 7, h = (v >> 3) & 3, b = v >> 5;
        const int t0 = b * S_ + qt * 256 + wave * 32;
        bf16x8 qf[16];
        { const bf16* qp = Q + (size_t)(t0 + r32) * 1024 + h * 256 + 8 * hh;
#pragma unroll
          for (int ks = 0; ks < 16; ++ks) qf[ks] = *(const bf16x8*)(qp + 16 * ks); }
        const bf16* kbase = KB + (size_t)(b * 256) * 1024 + h * 256;
        const bf16* vbase = VT + (size_t)(h * 256) * 8192 + b * 256;
#define AT_DMAK(c, buf) do { const char* kc_ = (const char*)kbase + (size_t)(c) * (64 * 1024 * 2); _Pragma("unroll") for (int i4 = 0; i4 < 4; ++i4) \
        __builtin_amdgcn_global_load_lds((const unsigned*)(kc_ + koff[i4]), (LAS unsigned*)(lds + (buf) * BUFB + (wave * 4 + i4) * 1024), 16, 0, 0); } while (0)
#define AT_DMAV(c, buf) do { const char* vc_ = (const char*)vbase + (size_t)(c) * (64 * 2); _Pragma("unroll") for (int i4 = 0; i4 < 4; ++i4) \
        __builtin_amdgcn_global_load_lds((const unsigned*)(vc_ + voff[i4]), (LAS unsigned*)(lds + (buf) * BUFB + (wave * 4 + i4) * 1024), 16, 0, 0); } while (0)
        f32x16 sacc[8];
#pragma unroll
        for (int k = 0; k < 8; ++k)
#pragma unroll
            for (int r = 0; r < 16; ++r) sacc[k][r] = 0.f;
        AT_DMAK(0, 0);
        const unsigned kx = (unsigned)(r32 * 512) ^ (unsigned)((hh ^ r32) << 4); unsigned kxv = kx;
#pragma unroll
        for (int c = 0; c < 4; ++c) {
            __syncthreads();
            if (c < 3) AT_DMAK(c + 1, (c + 1) & 1); else AT_DMAV(0, 0);
            { const LAS unsigned char* kb = lds + (c & 1) * BUFB;
              bf16x8 ka[3][2];
#define AT_RDK(buf_, ks_) do { _Pragma("unroll") for (int kt2 = 0; kt2 < 2; ++kt2) ka[buf_][kt2] = *(const LAS bf16x8*)(kb + kt2 * (32 * 512) + (kxv ^ (unsigned)(32 * (ks_)))); } while (0)
              asm volatile("" : "+v"(kxv));
              AT_RDK(0, 0); AT_RDK(1, 1);
#pragma unroll
              for (int ks = 0; ks < 16; ++ks) {
                  if (ks + 2 < 16) { if ((ks & 3) == 2) asm volatile("" : "+v"(kxv)); AT_RDK((ks + 2) % 3, ks + 2); }
                  __builtin_amdgcn_sched_barrier(0);
#pragma unroll
                  for (int kt2 = 0; kt2 < 2; ++kt2) sacc[2 * c + kt2] = __builtin_amdgcn_mfma_f32_32x32x16_bf16(ka[ks % 3][kt2], qf[ks], sacc[2 * c + kt2], 0, 0, 0);
                  __builtin_amdgcn_sched_barrier(0); }
#undef AT_RDK
            }
        }
        float m = sacc[0][0];
#pragma unroll
        for (int k = 0; k < 8; ++k)
#pragma unroll
            for (int r = 0; r < 16; ++r) m = fmaxf(m, sacc[k][r]);
        m = fmaxf(m, __shfl_xor(m, 32));
        const float sc = 0.0625f * 1.4426950408889634f; const float msc = m * sc; float sum = 0.f;
#pragma unroll
        for (int k = 0; k < 8; ++k)
#pragma unroll
            for (int r = 0; r < 16; ++r) { const float p = __builtin_amdgcn_exp2f(sacc[k][r] * sc - msc); sacc[k][r] = p; sum += p; }
        sum += __shfl_xor(sum, 32);
        const float inv = 1.0f / sum;
        bf16x8 pf[8][2];
#pragma unroll
        for (int k = 0; k < 8; ++k)
#pragma unroll
            for (int s2 = 0; s2 < 2; ++s2) { v4u w; w.x = pg8::cvt_pk_bf16(sacc[k][8 * s2 + 0], sacc[k][8 * s2 + 1]); w.y = pg8::cvt_pk_bf16(sacc[k][8 * s2 + 2], sacc[k][8 * s2 + 3]);
                w.z = pg8::cvt_pk_bf16(sacc[k][8 * s2 + 4], sacc[k][8 * s2 + 5]); w.w = pg8::cvt_pk_bf16(sacc[k][8 * s2 + 6], sacc[k][8 * s2 + 7]); pf[k][s2] = __builtin_bit_cast(bf16x8, w); }
        f32x16 oacc[8];
#pragma unroll
        for (int k = 0; k < 8; ++k)
#pragma unroll
            for (int r = 0; r < 16; ++r) oacc[k][r] = 0.f;
        const unsigned vx = (unsigned)(r32 * 128 + 8 * hh) ^ (unsigned)(((r32 >> 1) & 7) << 4); unsigned vxv = vx;
#pragma unroll
        for (int c = 0; c < 4; ++c) {
            __syncthreads();
            if (c < 3) AT_DMAV(c + 1, (c + 1) & 1);
            { const LAS unsigned char* vb0 = lds + (c & 1) * BUFB;
              bf16x8 va[2][2][2];
#define AT_RDV(buf_, bt_) do { const LAS unsigned char* vb_ = vb0 + ((bt_) >> 1) * 2 * (32 * 128); _Pragma("unroll") for (int k_ = 0; k_ < 2; ++k_) _Pragma("unroll") for (int d2 = 0; d2 < 2; ++d2) { \
                  const int kk_ = 2 * ((bt_) & 1) + k_; const bf16x4 a0_ = *(const LAS bf16x4*)(vb_ + d2 * (32 * 128) + (vxv ^ (unsigned)(32 * kk_))), a1_ = *(const LAS bf16x4*)(vb_ + d2 * (32 * 128) + (vxv ^ (unsigned)(32 * kk_ + 16))); \
                  va[buf_][d2][k_] = __builtin_shufflevector(a0_, a1_, 0, 1, 2, 3, 4, 5, 6, 7); } } while (0)
              asm volatile("" : "+v"(vxv));
              AT_RDV(0, 0);
#pragma unroll
              for (int bt = 0; bt < 8; ++bt) {
                  if (bt < 7) { if ((bt & 1) == 1) asm volatile("" : "+v"(vxv)); AT_RDV((bt + 1) & 1, bt + 1); }
                  __builtin_amdgcn_sched_barrier(0);
#pragma unroll
                  for (int k_ = 0; k_ < 2; ++k_)
#pragma unroll
                      for (int d2 = 0; d2 < 2; ++d2) { const int kk = 2 * (bt & 1) + k_, dt = 2 * (bt >> 1) + d2;
                          oacc[dt] = __builtin_amdgcn_mfma_f32_32x32x16_bf16(va[bt & 1][d2][k_], pf[2 * c + (kk >> 1)][kk & 1], oacc[dt], 0, 0, 0); }
                  __builtin_amdgcn_sched_barrier(0); }
#undef AT_RDV
            }
        }
        __syncthreads();
        LAS unsigned char* ow = lds + wave * (32 * OP);
#pragma unroll
        for (int dt = 0; dt < 8; ++dt)
#pragma unroll
            for (int rg = 0; rg < 4; ++rg) { const f32x16& oa = oacc[dt];
                *(LAS unsigned*)(ow + r32 * OP + 32 * dt + 8 * rg + 4 * hh) = pg8::cvt4_fp8(oa[4 * rg] * inv, oa[4 * rg + 1] * inv, oa[4 * rg + 2] * inv, oa[4 * rg + 3] * inv); }
        LDS_WAIT(); asm volatile("" ::: "memory");
#pragma unroll
        for (int it = 0; it < 8; ++it) { const int idx = it * 64 + lane, row = idx >> 4, ch = idx & 15;
            const v4u w = *(const LAS v4u*)(ow + row * OP + ch * 16);
            *(v4u*)(O + (size_t)(t0 + row) * 1024 + h * 256 + ch * 16) = w; }
        LDS_WAIT(); asm volatile("" ::: "memory");
        __syncthreads();
#undef AT_DMAK
#undef AT_DMAV
    }
}

__device__ __forceinline__ f32x2v fast_gelu2(f32x2v x) {
    const f32x2v x2 = x * x, u = x * (x2 * 0.035677408136300125f + 0.7978845608028654f), t = u * (-2.885390081777927f);
    f32x2v e; e.x = __builtin_amdgcn_exp2f(t.x); e.y = __builtin_amdgcn_exp2f(t.y);
    const f32x2v d = e + 1.0f; f32x2v r; r.x = __builtin_amdgcn_rcpf(d.x); r.y = __builtin_amdgcn_rcpf(d.y);
    return x * r;
}
__device__ __forceinline__ float fast_gelu(float x) { const float u = x * (0.7978845608028654f + 0.035677408136300125f * x * x); return x * __builtin_amdgcn_rcpf(1.0f + __builtin_amdgcn_exp2f(-2.885390081777927f * u)); }
typedef short s16x4 __attribute__((ext_vector_type(4)));
__device__ __forceinline__ s16x4 lds_tr16(const LAS unsigned char* p) { return __builtin_bit_cast(s16x4, __builtin_amdgcn_ds_read_tr16_b64_v4i16((LAS s16x4*)p)); }
__device__ __forceinline__ void gmlp_unit(LAS unsigned char* lds, const bf16* PROJ, const bf16* WSP, const float* ln_gain, const float* bsp, const float* beta, bf16* Y, int unit) {
    typedef short bf16x8 __attribute__((ext_vector_type(8)));
    typedef float f32x16 __attribute__((ext_vector_type(16)));
    typedef unsigned v2u __attribute__((ext_vector_type(2)));
    const int tid = threadIdx.x, lane = tid & 63, wave = __builtin_amdgcn_readfirstlane(tid >> 6), r32 = lane & 31, hh = lane >> 5;
    constexpr int VP = 1088, UP = 1032, RED_OFF = 128 * UP;
    const size_t tok0 = (size_t)unit * 128;
    const int tt = wave >> 1, chf = wave & 1;
    bf16x8 wfc[8];
#pragma unroll
    for (int ks = 0; ks < 8; ++ks) wfc[ks] = *(const bf16x8*)(WSP + ((size_t)(32 * tt + r32)) * 128 + 16 * ks + 8 * hh);
    { v4u raw[16];
#pragma unroll
      for (int i = 0; i < 16; ++i) raw[i] = *(const v4u*)(PROJ + (tok0 + wave * 16 + i) * NPROJ + 512 + lane * 8);
      float gn[8];
#pragma unroll
      for (int j = 0; j < 8; ++j) gn[j] = ln_gain[lane * 8 + j];
#pragma unroll
      for (int i = 0; i < 16; ++i) { const int t = wave * 16 + i;
        const unsigned rw[4] = {raw[i].x, raw[i].y, raw[i].z, raw[i].w};
        float g[8]; float s = 0.f, q = 0.f;
#pragma unroll
        for (int j = 0; j < 4; ++j) { const f32x2v gg = fast_gelu2((f32x2v){__uint_as_float(rw[j] << 16), __uint_as_float(rw[j] & 0xffff0000u)}); g[2 * j] = gg.x; g[2 * j + 1] = gg.y; s += gg.x + gg.y; q += gg.x * gg.x + gg.y * gg.y; }
        s = wave_sum_dpp(s); q = wave_sum_dpp(q);
        const float mean = s * (1.f / 512.f), var = fmaxf(q * (1.f / 512.f) - mean * mean, 0.f);
        const float rstd = __builtin_amdgcn_rsqf(var + EPS);
        v4u o; o.x = pg8::cvt_pk_bf16((g[0] - mean) * rstd * gn[0], (g[1] - mean) * rstd * gn[1]); o.y = pg8::cvt_pk_bf16((g[2] - mean) * rstd * gn[2], (g[3] - mean) * rstd * gn[3]);
        o.z = pg8::cvt_pk_bf16((g[4] - mean) * rstd * gn[4], (g[5] - mean) * rstd * gn[5]); o.w = pg8::cvt_pk_bf16((g[6] - mean) * rstd * gn[6], (g[7] - mean) * rstd * gn[7]);
        *(LAS v4u*)(lds + t * VP + lane * 16) = o; } }
    __syncthreads();
    f32x16 acc[4][2];
#pragma unroll
    for (int g = 0; g < 4; ++g)
#pragma unroll
        for (int c2 = 0; c2 < 2; ++c2)
#pragma unroll
            for (int r = 0; r < 16; ++r) acc[g][c2][r] = 0.f;
    { const int q4 = (lane & 15) >> 2, p4 = lane & 3, blk = (lane >> 4) & 1;
      const LAS unsigned char* vtr0 = lds + (8 * hh + q4) * VP + (16 * blk + 4 * p4) * 2;
#pragma unroll
      for (int g = 0; g < 4; ++g) {
        bf16x8 wfn[8];
        if (g < 3) {
#pragma unroll
            for (int ks = 0; ks < 8; ++ks) wfn[ks] = *(const bf16x8*)(WSP + ((size_t)(g + 1) * 128 + 32 * tt + r32) * 128 + 16 * ks + 8 * hh); }
#pragma unroll
        for (int ks = 0; ks < 8; ++ks) if (ks < 2 * tt + 2) {
#pragma unroll
            for (int c2 = 0; c2 < 2; ++c2) { const LAS unsigned char* pa = vtr0 + ks * 16 * VP + (g * 128 + 32 * (2 * chf + c2)) * 2;
                const s16x4 a0 = lds_tr16(pa), a1 = lds_tr16(pa + 4 * VP);
                const bf16x8 a = __builtin_shufflevector(a0, a1, 0, 1, 2, 3, 4, 5, 6, 7);
                acc[g][c2] = __builtin_amdgcn_mfma_f32_32x32x16_bf16(a, wfc[ks], acc[g][c2], 0, 0, 0); } }
        if (g < 3) {
#pragma unroll
            for (int ks = 0; ks < 8; ++ks) wfc[ks] = wfn[ks]; }
      } }
    __syncthreads();
    v4u rawu[16];
#pragma unroll
    for (int i = 0; i < 16; ++i) rawu[i] = *(const v4u*)(PROJ + (tok0 + wave * 16 + i) * NPROJ + lane * 8);
    float biasv[4];
#pragma unroll
    for (int g = 0; g < 4; ++g) biasv[g] = bsp[g * 128 + 32 * tt + r32];
#pragma unroll
    for (int i = 0; i < 16; ++i) { const int t = wave * 16 + i;
        const unsigned rw[4] = {rawu[i].x, rawu[i].y, rawu[i].z, rawu[i].w};
        unsigned o[4];
#pragma unroll
        for (int j = 0; j < 4; ++j) { const f32x2v gg = fast_gelu2((f32x2v){__uint_as_float(rw[j] << 16), __uint_as_float(rw[j] & 0xffff0000u)}); o[j] = pg8::cvt_pk_bf16(gg.x, gg.y); }
        *(LAS v2u*)(lds + t * UP + lane * 16) = (v2u){o[0], o[1]}; *(LAS v2u*)(lds + t * UP + lane * 16 + 8) = (v2u){o[2], o[3]}; }
    __syncthreads();
    const int tl = 32 * tt + r32;
    float ssq = 0.f;
#pragma unroll
    for (int g = 0; g < 4; ++g) { const float bias = biasv[g];
#pragma unroll
        for (int c2 = 0; c2 < 2; ++c2)
#pragma unroll
            for (int rg = 0; rg < 4; ++rg) { const int ch = g * 128 + 32 * (2 * chf + c2) + 8 * rg + 4 * hh;
                const v2u uu = *(const LAS v2u*)(lds + tl * UP + ch * 2);
                const float u0 = __uint_as_float(uu.x << 16), u1 = __uint_as_float(uu.x & 0xffff0000u), u2 = __uint_as_float(uu.y << 16), u3 = __uint_as_float(uu.y & 0xffff0000u);
                float y0 = u0 * (acc[g][c2][4 * rg] + bias), y1 = u1 * (acc[g][c2][4 * rg + 1] + bias), y2 = u2 * (acc[g][c2][4 * rg + 2] + bias), y3 = u3 * (acc[g][c2][4 * rg + 3] + bias);
                acc[g][c2][4 * rg] = y0; acc[g][c2][4 * rg + 1] = y1; acc[g][c2][4 * rg + 2] = y2; acc[g][c2][4 * rg + 3] = y3;
                ssq += (y0 * y0 + y1 * y1) + (y2 * y2 + y3 * y3); } }
    ssq += __shfl_xor(ssq, 32);
    LAS float* red = (LAS float*)(lds + RED_OFF);
    if (hh == 0) red[tl * 2 + chf] = ssq;
    __syncthreads();
    const float rn = 1.0f / sqrtf((red[tl * 2] + red[tl * 2 + 1]) * (1.f / 512.f) + EPS);
#pragma unroll
    for (int g = 0; g < 4; ++g) {
        f32x4 btv[2][4];
#pragma unroll
        for (int c2 = 0; c2 < 2; ++c2)
#pragma unroll
            for (int rg = 0; rg < 4; ++rg) btv[c2][rg] = *(const f32x4*)(beta + g * 128 + 32 * (2 * chf + c2) + 8 * rg + 4 * hh);
        __builtin_amdgcn_sched_barrier(0);
#pragma unroll
        for (int c2 = 0; c2 < 2; ++c2)
#pragma unroll
            for (int rg = 0; rg < 4; ++rg) { const int ch = g * 128 + 32 * (2 * chf + c2) + 8 * rg + 4 * hh;
                const f32x4 bt = btv[c2][rg];
                v2u w; w.x = pg8::cvt_pk_bf16(acc[g][c2][4 * rg] * rn * bt.x, acc[g][c2][4 * rg + 1] * rn * bt.y); w.y = pg8::cvt_pk_bf16(acc[g][c2][4 * rg + 2] * rn * bt.z, acc[g][c2][4 * rg + 3] * rn * bt.w);
                *(LAS v2u*)(lds + tl * UP + ch * 2) = w; } }
    __syncthreads();
    { const LAS unsigned char* sp = lds + (tid >> 7) * UP + (tid & 127) * 8; bf16* gp = Y + (tok0 + (tid >> 7)) * 1024 + (tid & 127) * 4;
#pragma unroll 4
      for (int it = 0; it < 32; ++it) { *(v2u*)(gp + (size_t)it * 4 * 1024) = *(const LAS v2u*)(sp + it * 4 * UP); } }
    __syncthreads();
}

__device__ __forceinline__ void hgrn_seq(LAS unsigned char* lds, const bf16* PROJ, const float* lb_logits, const float* out_gain, bf16* Y, int seq, int nchunks) {
    typedef short bf16x8 __attribute__((ext_vector_type(8)));
    typedef float f32x16 __attribute__((ext_vector_type(16)));
    typedef unsigned v2u __attribute__((ext_vector_type(2)));
    const int tid = threadIdx.x, lane = tid & 63, wave = __builtin_amdgcn_readfirstlane(tid >> 6), r32 = lane & 31, hh = lane >> 5;
    const int b = seq >> 2, h = seq & 3;
    constexpr int QP = 272, TP = 320, GP = 264;
    constexpr int QD_O = 0, KI_O = 17408, KE_O = 34816, VV_O = 55296, GG_O = 75776, ST_O = 92672, SEG_O = 133632, DEC_O = 137728, SSQ_O = 138240;
#define HG_OFFB(row, ch) (256 * (row) + 16 * ((ch) ^ ((((row) & 3) << 2) | (((row) >> 2) & 3))))
    LAS float* SEG = (LAS float*)(lds + SEG_O); LAS float* DEC = (LAS float*)(lds + DEC_O); LAS float* SSQ = (LAS float*)(lds + SSQ_O);
    const float L2E = 1.4426950408889634f;
    float lb[2], og[2];
#pragma unroll
    for (int c = 0; c < 2; ++c) { const int ch = h * 128 + 2 * lane + c; const float l0 = lb_logits[ch], l1 = lb_logits[512 + ch], mx = fmaxf(l0, l1), e0 = __expf(l0 - mx), e1 = __expf(l1 - mx);
        lb[c] = e0 / (e0 + e1); og[c] = out_gain[ch]; }
    for (int i = tid; i < 128 * 256 / 4; i += 512) ((LAS unsigned*)(lds + ST_O))[i] = 0u;
    const int vt = wave & 3, it = wave >> 2;
    f32x16 stacc[2];
#pragma unroll
    for (int dd = 0; dd < 2; ++dd)
#pragma unroll
        for (int r = 0; r < 16; ++r) stacc[dd][r] = 0.f;
    const int q4 = (lane & 15) >> 2, p4 = lane & 3, blk = (lane >> 4) & 1;
    const int trc = (16 * blk + 4 * p4) * 2;
    unsigned rq[8], rf[8], rv[8], rg[8];
#define HG_LOAD(nn) do { const size_t tb_ = (size_t)b * S_ + (size_t)(nn) * 64; _Pragma("unroll") for (int k = 0; k < 8; ++k) { const bf16* row = PROJ + (tb_ + 8 * wave + k) * NPROJ + h * 128 + 2 * lane; \
        rq[k] = *(const unsigned*)(row + 1024); rf[k] = *(const unsigned*)(row + 1536); rv[k] = *(const unsigned*)(row + 2048); rg[k] = *(const unsigned*)(row + 2560); } } while (0)
    HG_LOAD(0);
    for (int n = 0; n < nchunks; ++n) {
        const size_t tb = (size_t)b * S_ + (size_t)n * 64;
        float kk0[8], kk1[8], cs0[8], cs1[8];
        { float run0 = 0.f, run1 = 0.f;
#pragma unroll
          for (int k = 0; k < 8; ++k) { const float x0 = __uint_as_float(rf[k] << 16), x1 = __uint_as_float(rf[k] & 0xffff0000u);
              const float s0 = __builtin_amdgcn_rcpf(1.0f + __builtin_amdgcn_exp2f(-L2E * x0)), s1 = __builtin_amdgcn_rcpf(1.0f + __builtin_amdgcn_exp2f(-L2E * x1));
              const float f0 = lb[0] + (1.0f - lb[0]) * s0, f1 = lb[1] + (1.0f - lb[1]) * s1;
              kk0[k] = 1.0f - f0; kk1[k] = 1.0f - f1; run0 += __builtin_amdgcn_logf(f0); run1 += __builtin_amdgcn_logf(f1); cs0[k] = run0; cs1[k] = run1; }
          *(LAS f32x2v*)(SEG + wave * 128 + 2 * lane) = (f32x2v){run0, run1}; }
        __syncthreads();
        { float off0 = 0.f, off1 = 0.f, tot0 = 0.f, tot1 = 0.f;
#pragma unroll
          for (int sgi = 0; sgi < 8; ++sgi) { const f32x2v sv = *(const LAS f32x2v*)(SEG + sgi * 128 + 2 * lane); tot0 += sv.x; tot1 += sv.y; if (sgi < wave) { off0 += sv.x; off1 += sv.y; } }
          const float et0 = __builtin_amdgcn_exp2f(tot0), et1 = __builtin_amdgcn_exp2f(tot1);
          if (wave == 0) *(LAS f32x2v*)(DEC + 2 * lane) = (f32x2v){et0, et1};
#pragma unroll
          for (int k = 0; k < 8; ++k) { const int t = 8 * wave + k;
              const float b0 = off0 + cs0[k], b1 = off1 + cs1[k];
              const float eb0 = __builtin_amdgcn_exp2f(b0), eb1 = __builtin_amdgcn_exp2f(b1), ib0 = __builtin_amdgcn_exp2f(-b0), ib1 = __builtin_amdgcn_exp2f(-b1);
              const float q0 = __uint_as_float(rq[k] << 16), q1 = __uint_as_float(rq[k] & 0xffff0000u), g0 = __uint_as_float(rg[k] << 16), g1 = __uint_as_float(rg[k] & 0xffff0000u);
              const float ki0 = kk0[k] * ib0, ki1 = kk1[k] * ib1;
              *(LAS unsigned*)(lds + QD_O + t * QP + 4 * lane) = pg8::cvt_pk_bf16(pg8::fast_silu(q0) * eb0, pg8::fast_silu(q1) * eb1);
              *(LAS unsigned*)(lds + KI_O + t * QP + 4 * lane) = pg8::cvt_pk_bf16(ki0, ki1);
              *(LAS unsigned*)(lds + KE_O + t * TP + 4 * lane) = pg8::cvt_pk_bf16(ki0 * et0, ki1 * et1);
              *(LAS unsigned*)(lds + VV_O + t * TP + 4 * lane) = rv[k];
              *(LAS unsigned*)(lds + GG_O + t * GP + 4 * lane) = pg8::cvt_pk_bf16(og[0] * pg8::fast_silu(g0), og[1] * pg8::fast_silu(g1)); } }
        __syncthreads();
        if (n + 1 < nchunks) HG_LOAD(n + 1);
        bf16x8 qf[8];
#pragma unroll
        for (int ks = 0; ks < 8; ++ks) qf[ks] = *(const LAS bf16x8*)(lds + QD_O + (32 * it + r32) * QP + (16 * ks + 8 * hh) * 2);
        f32x16 oacc;
#pragma unroll
        for (int r = 0; r < 16; ++r) oacc[r] = 0.f;
#pragma unroll
        for (int ks = 0; ks < 8; ++ks) { const int rw0 = 16 * ks + 8 * hh + q4, chh = 4 * vt + 2 * blk + (p4 >> 1);
            const s16x4 a0 = lds_tr16(lds + ST_O + HG_OFFB(rw0, chh) + 8 * (p4 & 1)), a1 = lds_tr16(lds + ST_O + HG_OFFB(rw0 + 4, chh) + 8 * (p4 & 1));
            oacc = __builtin_amdgcn_mfma_f32_32x32x16_bf16(__builtin_shufflevector(a0, a1, 0, 1, 2, 3, 4, 5, 6, 7), qf[ks], oacc, 0, 0, 0); }
#pragma unroll
        for (int jt = 0; jt < 2; ++jt) if (jt <= it) {
            f32x16 sx;
#pragma unroll
            for (int r = 0; r < 16; ++r) sx[r] = 0.f;
#pragma unroll
            for (int ks = 0; ks < 8; ++ks) { const bf16x8 a = *(const LAS bf16x8*)(lds + KI_O + (32 * jt + r32) * QP + (16 * ks + 8 * hh) * 2);
                sx = __builtin_amdgcn_mfma_f32_32x32x16_bf16(a, qf[ks], sx, 0, 0, 0); }
            if (jt == it) {
#pragma unroll
                for (int r = 0; r < 16; ++r) { const int jl = (r & 3) + 8 * (r >> 2) + 4 * hh; sx[r] = (jl <= r32) ? sx[r] : 0.f; } }
#pragma unroll
            for (int s2 = 0; s2 < 2; ++s2) {
                v4u w; w.x = pg8::cvt_pk_bf16(sx[8 * s2 + 0], sx[8 * s2 + 1]); w.y = pg8::cvt_pk_bf16(sx[8 * s2 + 2], sx[8 * s2 + 3]); w.z = pg8::cvt_pk_bf16(sx[8 * s2 + 4], sx[8 * s2 + 5]); w.w = pg8::cvt_pk_bf16(sx[8 * s2 + 6], sx[8 * s2 + 7]);
                const LAS unsigned char* pa = lds + VV_O + (32 * jt + 16 * s2 + 4 * hh + q4) * TP + 64 * vt + trc;
                const s16x4 a0 = lds_tr16(pa), a1 = lds_tr16(pa + 8 * TP);
                oacc = __builtin_amdgcn_mfma_f32_32x32x16_bf16(__builtin_shufflevector(a0, a1, 0, 1, 2, 3, 4, 5, 6, 7), __builtin_bit_cast(bf16x8, w), oacc, 0, 0, 0); }
        }
#pragma unroll
        for (int dd = 0; dd < 2; ++dd) { const int dt = 2 * it + dd; const float dec = DEC[32 * dt + r32];
#pragma unroll
            for (int r = 0; r < 16; ++r) stacc[dd][r] *= dec;
#pragma unroll
            for (int ks = 0; ks < 4; ++ks) { const LAS unsigned char* pa = lds + VV_O + (16 * ks + 8 * hh + q4) * TP + 64 * vt + trc; const LAS unsigned char* pb = lds + KE_O + (16 * ks + 8 * hh + q4) * TP + 64 * dt + trc;
                const s16x4 a0 = lds_tr16(pa), a1 = lds_tr16(pa + 4 * TP), b0 = lds_tr16(pb), b1 = lds_tr16(pb + 4 * TP);
                stacc[dd] = __builtin_amdgcn_mfma_f32_32x32x16_bf16(__builtin_shufflevector(a0, a1, 0, 1, 2, 3, 4, 5, 6, 7), __builtin_shufflevector(b0, b1, 0, 1, 2, 3, 4, 5, 6, 7), stacc[dd], 0, 0, 0); } }
        { float ssq = 0.f;
#pragma unroll
          for (int r = 0; r < 16; ++r) ssq += oacc[r] * oacc[r];
          ssq += __shfl_xor(ssq, 32);
          if (hh == 0) SSQ[(32 * it + r32) * 4 + vt] = ssq; }
        __syncthreads();
        { const int il = 32 * it + r32; const f32x4 sq = *(const LAS f32x4*)(SSQ + il * 4);
          const float rn = 1.0f / sqrtf(((sq.x + sq.y) + (sq.z + sq.w)) * (1.f / 128.f) + EPS);
#pragma unroll
          for (int rg4 = 0; rg4 < 4; ++rg4) { const int v0 = 32 * vt + 8 * rg4 + 4 * hh;
              const v2u gg = *(const LAS v2u*)(lds + GG_O + il * GP + v0 * 2);
              v2u w; w.x = pg8::cvt_pk_bf16(oacc[4 * rg4] * rn * __uint_as_float(gg.x << 16), oacc[4 * rg4 + 1] * rn * __uint_as_float(gg.x & 0xffff0000u));
              w.y = pg8::cvt_pk_bf16(oacc[4 * rg4 + 2] * rn * __uint_as_float(gg.y << 16), oacc[4 * rg4 + 3] * rn * __uint_as_float(gg.y & 0xffff0000u));
              *(LAS v2u*)(lds + QD_O + il * GP + v0 * 2) = w; }
#pragma unroll
          for (int dd = 0; dd < 2; ++dd) { const int d = 32 * (2 * it + dd) + r32;
#pragma unroll
              for (int rg4 = 0; rg4 < 4; ++rg4) { const int v0 = 32 * vt + 8 * rg4 + 4 * hh;
                  v2u w; w.x = pg8::cvt_pk_bf16(stacc[dd][4 * rg4], stacc[dd][4 * rg4 + 1]); w.y = pg8::cvt_pk_bf16(stacc[dd][4 * rg4 + 2], stacc[dd][4 * rg4 + 3]);
                  *(LAS v2u*)(lds + ST_O + HG_OFFB(d, 4 * vt + rg4) + 8 * hh) = w; } } }
        __syncthreads();
#pragma unroll
        for (int i4 = 0; i4 < 4; ++i4) { const int idx = i4 * 512 + tid, row = idx >> 5, pc = idx & 31;
            const v2u w = *(const LAS v2u*)(lds + QD_O + row * GP + pc * 8);
            *(v2u*)(Y + (tb + row) * 1024 + 512 + h * 128 + pc * 4) = w; }
    }
    __syncthreads();
#undef HG_LOAD
#undef HG_OFFB
}

__device__ __forceinline__ void rms_rows4_to_bf16(const float* xrow, const float* gain, bf16* orow, int lane, float* invr = nullptr, bool f8 = false) {
    f32x4 v[4][4]; float s[4]; f32x4 gq[4];
#pragma unroll
    for (int r = 0; r < 4; ++r)
#pragma unroll
        for (int j = 0; j < 4; ++j) v[r][j] = ((const GAS f32x4*)(xrow + (size_t)r * 1024))[lane + 64 * j];
#pragma unroll
    for (int j = 0; j < 4; ++j) gq[j] = ((const GAS f32x4*)gain)[lane + 64 * j];
#pragma unroll
    for (int r = 0; r < 4; ++r) { s[r] = 0.f;
#pragma unroll
        for (int j = 0; j < 4; ++j) s[r] += (v[r][j].x * v[r][j].x + v[r][j].y * v[r][j].y) + (v[r][j].z * v[r][j].z + v[r][j].w * v[r][j].w); }
#pragma unroll
    for (int r = 0; r < 4; ++r) s[r] = wave_sum_dpp(s[r]);
    if (invr && lane < 4) { const float sv = lane == 0 ? s[0] : (lane == 1 ? s[1] : (lane == 2 ? s[2] : s[3])); invr[lane] = sqrtf(sv * (1.f / 1024.f) + EPS); }
#pragma unroll
    for (int j = 0; j < 4; ++j) { const f32x4 g = gq[j];
#pragma unroll
        for (int r = 0; r < 4; ++r) { const float rr = __builtin_amdgcn_rsqf(s[r] * (1.f / 1024.f) + EPS);
            if (f8) { ((GAS unsigned*)((unsigned char*)orow + (size_t)r * 1024))[lane + 64 * j] = pg8::cvt4_fp8(v[r][j].x * rr * g.x, v[r][j].y * rr * g.y, v[r][j].z * rr * g.z, v[r][j].w * rr * g.w); continue; }
            ((GAS unsigned long long*)(orow + (size_t)r * 1024))[lane + 64 * j] = (unsigned long long)pg8::cvt_pk_bf16(v[r][j].x * rr * g.x, v[r][j].y * rr * g.y) | ((unsigned long long)pg8::cvt_pk_bf16(v[r][j].z * rr * g.z, v[r][j].w * rr * g.w) << 32); } }
}

__device__ __forceinline__ void hgrn_seq2(LAS unsigned char* lds, const bf16* PROJ, const float* lb_logits, const float* out_gain, bf16* Y, int seq, int nchunks) {
    typedef short bf16x8 __attribute__((ext_vector_type(8)));
    typedef float f32x16 __attribute__((ext_vector_type(16)));
    typedef unsigned v2u __attribute__((ext_vector_type(2)));
    const int tid = threadIdx.x, lane = tid & 63, wave = __builtin_amdgcn_readfirstlane(tid >> 6), r32 = lane & 31, hh = lane >> 5;
    const int b = seq >> 2, h = seq & 3;
    constexpr int QP = 272, TP = 320, GP = 264;
    constexpr int QD_O = 0, KI_O = 17408, VV_O = 33792, SETSZ = 54272, ST_O = 108544, OST_O = 141312, SEG_O = 158208, DEC_O = 160256, SSQ_O = 161280, OGL_O = 162304;
#define HG_OFFB(row, ch) (256 * (row) + 16 * ((ch) ^ ((((row) & 3) << 2) | (((row) >> 2) & 3))))
    LAS float* SEG = (LAS float*)(lds + SEG_O); LAS float* DEC = (LAS float*)(lds + DEC_O); LAS float* SSQ = (LAS float*)(lds + SSQ_O);
    const float L2E = 1.4426950408889634f;
    for (int i = tid; i < 128 * 256 / 4; i += 512) ((LAS unsigned*)(lds + ST_O))[i] = 0u;
    if (tid < 128) ((LAS float*)(lds + OGL_O))[tid] = out_gain[h * 128 + tid];
    if (wave < 4) {
        const int pw = wave;
        float lb[2];
#pragma unroll
        for (int c = 0; c < 2; ++c) { const int ch = h * 128 + 2 * lane + c; const float l0 = lb_logits[ch], l1 = lb_logits[512 + ch], mx = fmaxf(l0, l1), e0 = __expf(l0 - mx), e1 = __expf(l1 - mx); lb[c] = e0 / (e0 + e1); }
        const f32x2v lbv = {lb[0], lb[1]}, omlb = {1.0f - lb[0], 1.0f - lb[1]};
        unsigned rqA[16], rfA[16], rvA[16], rqB[16], rfB[16], rvB[16];
#define HG2_LOAD(nn, RQ, RF, RV) do { const size_t tb_ = (size_t)b * S_ + (size_t)(nn) * 64; _Pragma("unroll") for (int k = 0; k < 16; ++k) { const bf16* row = PROJ + (tb_ + 16 * pw + k) * NPROJ + h * 128 + 2 * lane; \
        RQ[k] = *(const unsigned*)(row + 1024); RF[k] = *(const unsigned*)(row + 1536); RV[k] = *(const unsigned*)(row + 2048); } } while (0)
#define HG2_PREP(nn, RQ, RF, RV) do { \
        f32x2v kk[16], cp[16];                                 \
        { f32x2v run = {1.f, 1.f}; \
          _Pragma("unroll") for (int k = 0; k < 16; ++k) { const f32x2v x = {__uint_as_float(RF[k] << 16), __uint_as_float(RF[k] & 0xffff0000u)}; const f32x2v t = x * (-L2E); \
              f32x2v e; e.x = __builtin_amdgcn_exp2f(t.x); e.y = __builtin_amdgcn_exp2f(t.y); const f32x2v d = e + 1.0f; f32x2v sg; sg.x = __builtin_amdgcn_rcpf(d.x); sg.y = __builtin_amdgcn_rcpf(d.y); \
              const f32x2v f = lbv + omlb * sg; kk[k] = 1.0f - f; run = run * f; cp[k] = run; } \
          *(LAS f32x2v*)(SEG + pw * 128 + 2 * lane) = run; } \
        __syncthreads();                                       \
        { f32x2v offp = {1.f, 1.f}, totp = {1.f, 1.f}; \
          _Pragma("unroll") for (int sgi = 0; sgi < 4; ++sgi) { const f32x2v sv = *(const LAS f32x2v*)(SEG + sgi * 128 + 2 * lane); totp = totp * sv; if (sgi < pw) offp = offp * sv; } \
          LAS unsigned char* set_ = lds + ((nn) & 1) * SETSZ; \
          if (pw == 0) *(LAS f32x2v*)(DEC + ((nn) & 1) * 128 + 2 * lane) = totp; \
          _Pragma("unroll") for (int k = 0; k < 16; ++k) { const int t = 16 * pw + k; \
              const f32x2v eb = offp * cp[k]; f32x2v ib; ib.x = __builtin_amdgcn_rcpf(eb.x); ib.y = __builtin_amdgcn_rcpf(eb.y); \
              const f32x2v q = {__uint_as_float(RQ[k] << 16), __uint_as_float(RQ[k] & 0xffff0000u)}; const f32x2v tq = q * (-L2E); \
              f32x2v eq; eq.x = __builtin_amdgcn_exp2f(tq.x); eq.y = __builtin_amdgcn_exp2f(tq.y); const f32x2v dq = eq + 1.0f; f32x2v rq_; rq_.x = __builtin_amdgcn_rcpf(dq.x); rq_.y = __builtin_amdgcn_rcpf(dq.y); \
              const f32x2v qd = q * rq_ * eb, ki = kk[k] * ib; \
              *(LAS unsigned*)(set_ + QD_O + t * QP + 4 * lane) = pg8::cvt_pk_bf16(qd.x, qd.y); \
              *(LAS unsigned*)(set_ + KI_O + HG_OFFB(t, lane >> 2) + 4 * (lane & 3)) = pg8::cvt_pk_bf16(ki.x, ki.y); \
              *(LAS unsigned*)(set_ + VV_O + t * TP + 4 * lane) = RV[k]; } } \
        if ((nn) + 2 < nchunks) HG2_LOAD((nn) + 2, RQ, RF, RV); \
        __syncthreads();                                       \
    } while (0)
        HG2_LOAD(0, rqA, rfA, rvA);
        if (nchunks > 1) HG2_LOAD(1, rqB, rfB, rvB);
        for (int n = 0; n < nchunks; n += 2) { HG2_PREP(n, rqA, rfA, rvA); HG2_PREP(n + 1, rqB, rfB, rvB); }
        __syncthreads(); __syncthreads();
#undef HG2_LOAD
#undef HG2_PREP
    } else {
        const int vt = wave - 4;
        const int q4 = (lane & 15) >> 2, p4 = lane & 3, blk = (lane >> 4) & 1;
        const int trc = (16 * blk + 4 * p4) * 2;
        const int c2 = 2 * blk + (p4 >> 1), f0 = (q4 << 2) | (2 * hh), f1 = (q4 << 2) | (2 * hh + 1);
        const int stb0 = ST_O + 256 * (8 * hh + q4) + 16 * ((4 * vt + c2) ^ f0) + 8 * (p4 & 1);
        const int stb1 = ST_O + 256 * (8 * hh + q4 + 4) + 16 * ((4 * vt + c2) ^ f1) + 8 * (p4 & 1);
        const int kt0 = 256 * (8 * hh + q4) + 16 * (c2 ^ f0) + 8 * (p4 & 1);
        const int kt1 = 256 * (8 * hh + q4 + 4) + 16 * (c2 ^ f1) + 8 * (p4 & 1);
        const int fr = ((r32 & 3) << 2) | ((r32 >> 2) & 3);
        const int kr = 256 * r32 + 16 * (hh ^ fr);
        const int swb = ST_O + 256 * r32 + 16 * ((4 * vt) ^ (fr & 12)) + 8 * hh, f3 = fr & 3;
        f32x16 stacc[4];
#pragma unroll
        for (int dt = 0; dt < 4; ++dt)
#pragma unroll
            for (int r = 0; r < 16; ++r) stacc[dt][r] = 0.f;
        const int t4 = tid - 256;
        const LAS unsigned char* ostr = lds + OST_O + (t4 >> 5) * GP + (t4 & 31) * 8;
        for (int n = 0; n <= nchunks; ++n) {
            const int c = n - 1;
            const size_t tb = (size_t)b * S_ + (size_t)(c < 0 ? 0 : c) * 64;
            f32x16 oacc[2]; v2u graw[2][4];
            if (c >= 1) {
                bf16* gp = Y + (tb - 64 + (t4 >> 5)) * 1024 + 512 + h * 128 + (t4 & 31) * 4;
#pragma unroll
                for (int i8 = 0; i8 < 8; ++i8) *(v2u*)(gp + (size_t)i8 * 8 * 1024) = *(const LAS v2u*)(ostr + i8 * 8 * GP); }
            if (c >= 0) {
                const int so = (c & 1) * SETSZ;
                const LAS unsigned char* set_ = lds + so;
                int krs = so + KI_O + kr, kts0 = so + KI_O + kt0, kts1 = so + KI_O + kt1;
                asm volatile("" : "+v"(krs), "+v"(kts0), "+v"(kts1));
#pragma unroll
                for (int it = 0; it < 2; ++it)
#pragma unroll
                    for (int rg4 = 0; rg4 < 4; ++rg4) graw[it][rg4] = *(const v2u*)(PROJ + (tb + 32 * it + r32) * NPROJ + 2560 + h * 128 + 32 * vt + 8 * rg4 + 4 * hh);
#pragma unroll
                for (int it = 0; it < 2; ++it) {
                    bf16x8 qf[8];
#pragma unroll
                    for (int ks = 0; ks < 8; ++ks) qf[ks] = *(const LAS bf16x8*)(set_ + QD_O + (32 * it + r32) * QP + (16 * ks + 8 * hh) * 2);
#pragma unroll
                    for (int r = 0; r < 16; ++r) oacc[it][r] = 0.f;
                    { bf16x8 af[8];
#pragma unroll
                      for (int ks = 0; ks < 8; ++ks) { const s16x4 a0 = lds_tr16(lds + stb0 + 4096 * ks), a1 = lds_tr16(lds + stb1 + 4096 * ks); af[ks] = __builtin_shufflevector(a0, a1, 0, 1, 2, 3, 4, 5, 6, 7); }
#pragma unroll
                      for (int ks = 0; ks < 8; ++ks) oacc[it] = __builtin_amdgcn_mfma_f32_32x32x16_bf16(af[ks], qf[ks], oacc[it], 0, 0, 0); }
#pragma unroll
                    for (int jt = 0; jt < 2; ++jt) if (jt <= it) {
                        bf16x8 kf[8], va[2];
#pragma unroll
                        for (int ks = 0; ks < 8; ++ks) kf[ks] = *(const LAS bf16x8*)(lds + 8192 * jt + (krs ^ (32 * ks)));
#pragma unroll
                        for (int s2 = 0; s2 < 2; ++s2) { const LAS unsigned char* pa = set_ + VV_O + (32 * jt + 16 * s2 + 4 * hh + q4) * TP + 64 * vt + trc;
                            const s16x4 a0 = lds_tr16(pa), a1 = lds_tr16(pa + 8 * TP); va[s2] = __builtin_shufflevector(a0, a1, 0, 1, 2, 3, 4, 5, 6, 7); }
                        f32x16 sx;
#pragma unroll
                        for (int r = 0; r < 16; ++r) sx[r] = 0.f;
#pragma unroll
                        for (int ks = 0; ks < 8; ++ks) sx = __builtin_amdgcn_mfma_f32_32x32x16_bf16(kf[ks], qf[ks], sx, 0, 0, 0);
                        { int lim = r32 + 32 * (it - jt); asm volatile("" : "+v"(lim));
#pragma unroll
                          for (int r = 0; r < 16; ++r) { const int jl = (r & 3) + 8 * (r >> 2) + 4 * hh; sx[r] = (jl <= lim) ? sx[r] : 0.f; } }
#pragma unroll
                        for (int s2 = 0; s2 < 2; ++s2) {
                            v4u w; w.x = pg8::cvt_pk_bf16(sx[8 * s2 + 0], sx[8 * s2 + 1]); w.y = pg8::cvt_pk_bf16(sx[8 * s2 + 2], sx[8 * s2 + 3]); w.z = pg8::cvt_pk_bf16(sx[8 * s2 + 4], sx[8 * s2 + 5]); w.w = pg8::cvt_pk_bf16(sx[8 * s2 + 6], sx[8 * s2 + 7]);
                            oacc[it] = __builtin_amdgcn_mfma_f32_32x32x16_bf16(va[s2], __builtin_bit_cast(bf16x8, w), oacc[it], 0, 0, 0); }
                    }
                    { float ssq = 0.f;
#pragma unroll
                      for (int r = 0; r < 16; ++r) ssq += oacc[it][r] * oacc[it][r];
                      ssq += __shfl_xor(ssq, 32);
                      if (hh == 0) SSQ[(32 * it + r32) * 4 + vt] = ssq; }
                }
                { bf16x8 vf[4];
#pragma unroll
                  for (int ks = 0; ks < 4; ++ks) { const LAS unsigned char* pa = set_ + VV_O + (16 * ks + 8 * hh + q4) * TP + 64 * vt + trc;
                      const s16x4 a0 = lds_tr16(pa), a1 = lds_tr16(pa + 4 * TP); vf[ks] = __builtin_shufflevector(a0, a1, 0, 1, 2, 3, 4, 5, 6, 7); }
#pragma unroll
                  for (int dt = 0; dt < 4; ++dt) { bf16x8 kb[4];
#pragma unroll
                      for (int ks = 0; ks < 4; ++ks) { const s16x4 b0 = lds_tr16(lds + 4096 * ks + (kts0 ^ (64 * dt))), b1 = lds_tr16(lds + 4096 * ks + (kts1 ^ (64 * dt))); kb[ks] = __builtin_shufflevector(b0, b1, 0, 1, 2, 3, 4, 5, 6, 7); }
#pragma unroll
                      for (int ks = 0; ks < 4; ++ks) stacc[dt] = __builtin_amdgcn_mfma_f32_32x32x16_bf16(vf[ks], kb[ks], stacc[dt], 0, 0, 0);
                      const float dec = DEC[(c & 1) * 128 + 32 * dt + r32];
#pragma unroll
                      for (int r = 0; r < 16; ++r) stacc[dt][r] *= dec; } }
            }
            __syncthreads();
            if (c >= 0) {
                f32x4 og4[4];
#pragma unroll
                for (int rg4 = 0; rg4 < 4; ++rg4) og4[rg4] = *(const LAS f32x4*)(lds + OGL_O + (32 * vt + 8 * rg4 + 4 * hh) * 4);
#pragma unroll
                for (int it = 0; it < 2; ++it) { const int il = 32 * it + r32; const f32x4 sq = *(const LAS f32x4*)(SSQ + il * 4);
                    const float rn = __builtin_amdgcn_rsqf(((sq.x + sq.y) + (sq.z + sq.w)) * (1.f / 128.f) + EPS);
#pragma unroll
                    for (int rg4 = 0; rg4 < 4; ++rg4) { const int v0 = 32 * vt + 8 * rg4 + 4 * hh; const v2u gg = graw[it][rg4];
                        const float g0 = og4[rg4].x * pg8::fast_silu(__uint_as_float(gg.x << 16)), g1 = og4[rg4].y * pg8::fast_silu(__uint_as_float(gg.x & 0xffff0000u));
                        const float g2 = og4[rg4].z * pg8::fast_silu(__uint_as_float(gg.y << 16)), g3 = og4[rg4].w * pg8::fast_silu(__uint_as_float(gg.y & 0xffff0000u));
                        v2u w; w.x = pg8::cvt_pk_bf16(oacc[it][4 * rg4] * rn * g0, oacc[it][4 * rg4 + 1] * rn * g1); w.y = pg8::cvt_pk_bf16(oacc[it][4 * rg4 + 2] * rn * g2, oacc[it][4 * rg4 + 3] * rn * g3);
                        *(LAS v2u*)(lds + OST_O + il * GP + v0 * 2) = w; } }
#pragma unroll
                for (int dt = 0; dt < 4; ++dt)
#pragma unroll
                    for (int rg4 = 0; rg4 < 4; ++rg4) { v2u w; w.x = pg8::cvt_pk_bf16(stacc[dt][4 * rg4], stacc[dt][4 * rg4 + 1]); w.y = pg8::cvt_pk_bf16(stacc[dt][4 * rg4 + 2], stacc[dt][4 * rg4 + 3]);
                        *(LAS v2u*)(lds + swb + 8192 * dt + 16 * (rg4 ^ f3)) = w; }
            }
            __syncthreads();
        }
        { bf16* gp = Y + ((size_t)b * S_ + (size_t)(nchunks - 1) * 64 + (t4 >> 5)) * 1024 + 512 + h * 128 + (t4 & 31) * 4;
#pragma unroll
          for (int i8 = 0; i8 < 8; ++i8) *(v2u*)(gp + (size_t)i8 * 8 * 1024) = *(const LAS v2u*)(ostr + i8 * 8 * GP); }
    }
    __syncthreads();
#undef HG_OFFB
}

struct Args { const float* in[25]; float* out; unsigned char* ws; int ph_lo, ph_hi, sub, pad; };

__global__ void __launch_bounds__(NWAVES * 64, 2) mk(Args args) {
    extern __shared__ __attribute__((aligned(16))) unsigned char lds_raw[];
    LAS unsigned char* lds = (LAS unsigned char*)lds_raw;
    volatile LAS unsigned* MISC = (volatile LAS unsigned*)(lds + MISC_OFF);
    const int tid = threadIdx.x, lane = tid & 63, wave = __builtin_amdgcn_readfirstlane(tid >> 6);
    const int G = gridDim.x;
    unsigned char* ws = args.ws;
    unsigned* ctl = (unsigned*)(ws + WS_CTL);
    for (int u = tid; u < (LDS_BYTES - LDSCTL_OFF) / 4; u += NWAVES * 64) ((LAS unsigned*)(lds + LDSCTL_OFF))[u] = 0u;
    __syncthreads();
    const int lo = args.ph_lo, hi = args.ph_hi;
    const bool multi = (hi - lo) > 1;
    XcdBarrier bar; bar.bar = ctl + CW_BAR; bar.x = 0; bar.st = nullptr;
    if (multi) bar = xcd_barrier_post(ctl + CW_BAR, MISC + 8);
#define IN(k) (lo <= (k) && (k) < hi)
#ifndef PROBE_K
#define PROBE_K (-1)
#endif
#ifndef PROBE_SUB
#define PROBE_SUB 3
#endif
#define SEAM(k) do { if (IN(k) && IN((k) + 1)) xcd_barrier(bar); } while (0)

    const float* x = args.in[0]; float* out = args.out;
    bf16* WIN = (bf16*)(ws + WS_WIN); bf16* WOUT = (bf16*)(ws + WS_WOUT); bf16* WXQ = (bf16*)(ws + WS_WXQ); bf16* WXKV = (bf16*)(ws + WS_WXKV); bf16* WXO = (bf16*)(ws + WS_WXO);
    bf16* WGU = (bf16*)(ws + WS_WGU); bf16* WDN = (bf16*)(ws + WS_WDN);
    bf16* A = (bf16*)(ws + WS_A); bf16* Y = (bf16*)(ws + WS_Y); bf16* MEMN = (bf16*)(ws + WS_MEMN); bf16* KV = (bf16*)(ws + WS_KV); bf16* PROJ = (bf16*)(ws + WS_PROJ);
    bf16* HID = (bf16*)(ws + WS_HID); bf16* YB = (bf16*)(ws + WS_YB); bf16* KBp = (bf16*)(ws + WS_KB); bf16* VTp = (bf16*)(ws + WS_VT);
    unsigned char* H1F8 = ws + WS_PROJ + 128 * MiB;
    unsigned char* O8 = ws + WS_PROJ;
    int* slot_tok = (int*)(ws + WS_SLOTTOK); float* slot_gate = (float*)(ws + WS_SLOTGATE); int* small = (int*)(ws + WS_SMALL);
    int* tok_e = (int*)(ws + WS_TOKE); float* tok_g = (float*)(ws + WS_TOKG); int* lpos = (int*)(ws + WS_LPOS); int* tok_slot = (int*)(ws + WS_TOKSLOT); int* hist = (int*)(ws + WS_HIST);
    float* invrs = (float*)(ws + WS_INVRS); float* invg = (float*)(ws + WS_INVRS + 256 * 1024);
    float* ssq1 = (float*)(ws + WS_PROJ + 256 * MiB);       float* rs = (float*)(ws + WS_RS); float* slot_rs = (float*)(ws + WS_SLOTRS); bf16* WRF = (bf16*)(ws + WS_WRF);
    const int gw = blockIdx.x * NWAVES + wave, NGW = G * NWAVES;

    if (IN(0)) {
        LAS float* scr = (LAS float*)(lds + RING_OFF + wave * 16384);
        constexpr int I_IN = 16 * 96, I_SQ = 16 * 32, I_KV = 16 * 64, I_E = 32 * 256;
        constexpr int NITEMS = I_IN + 3 * I_SQ + I_KV + (TAIL_GATE ? 0 : 1) * I_E;
        for (int it = gw; it < NITEMS; it += NGW) {
            int r = it;
            if (r < I_IN) { p0_transpose_item(args.in[3], 1024, 3072, WIN, 0, scr, r / 96, r % 96, lane); continue; } r -= I_IN;
            if (r < I_SQ) { p0_transpose_item(args.in[10], 1024, 1024, WOUT, 0, scr, r / 32, r % 32, lane); continue; } r -= I_SQ;
            if (r < I_SQ) { p0_transpose_item8(args.in[13], 1024, 1024, (unsigned char*)WXQ, 0, scr, r / 32, r % 32, lane, 64.0f, args.in[11]); continue; } r -= I_SQ;
            if (r < I_KV) { p0_transpose_item8(args.in[14], 1024, 2048, (unsigned char*)WXKV, 0, scr, r / 64, r % 64, lane, 64.0f); continue; } r -= I_KV;
            if (r < I_SQ) { p0_transpose_item8(args.in[15], 1024, 1024, (unsigned char*)WXO, 0, scr, r / 32, r % 32, lane, 64.0f); continue; } r -= I_SQ;
            {
                const int up = r >= I_E; if (up) r -= I_E;
                const int e = r >> 8, q = r & 255, kb = q >> 4, nb = q & 15, n0 = 32 * nb, dest = 256 * (n0 >> 7) + (n0 & 127) + (up ? 128 : 0);
                p0_transpose_item8(args.in[up ? 22 : 21] + (size_t)e * 1024 * 512, 1024, 512, (unsigned char*)WGU + (size_t)e * 1024 * 1024, dest - n0, scr, kb, nb, lane, 64.0f); }
        }
        for (int it = blockIdx.x * 512 + tid; it < 32 * 3 * 64; it += G * 512) {
            const int l = it & 63, nt = (it >> 6) % 3, ks = it / 192, n = 16 * nt + (l & 15), k0 = 32 * ks + 8 * (l >> 4);
            float w[8]; unsigned hi[4], lo[4];
#pragma unroll
            for (int j = 0; j < 8; ++j) w[j] = ((n < 4) ? args.in[17][(size_t)(k0 + j) * 4 + n] : (n < 36 ? args.in[19][(size_t)(k0 + j) * 32 + (n - 4)] : 0.f)) * args.in[16][k0 + j];
#pragma unroll
            for (int j = 0; j < 4; ++j) { const bf16 h0 = f2bf(w[2 * j]), h1 = f2bf(w[2 * j + 1]); hi[j] = (unsigned)h0 | ((unsigned)h1 << 16); lo[j] = pk2(w[2 * j] - bf2f(h0), w[2 * j + 1] - bf2f(h1)); }
            v4u* dst = (v4u*)(WRF + ((size_t)((ks * 3 + nt) * 2) * 64 + l) * 8);
            dst[0] = (v4u){hi[0], hi[1], hi[2], hi[3]}; dst[64] = (v4u){lo[0], lo[1], lo[2], lo[3]};
        }
        { bf16* WSPw = (bf16*)(ws + WS_WSP);
          for (int it = blockIdx.x * 512 + tid; it < 4 * 128 * 128; it += G * 512) { const int sI = it & 127, tI = (it >> 7) & 127; WSPw[it] = (sI <= tI) ? f2bf(args.in[5][it]) : (bf16)0; } }
        for (int m = gw * 4; m < T_; m += NGW * 4) rms_rows4_to_bf16(x + (size_t)m * 1024, args.in[2], A + (size_t)m * 1024, lane, invrs + m);
        for (int i = blockIdx.x * 512 + tid; i < 1024; i += G * 512) invg[i] = 1.0f / args.in[2][i];
        for (int m = gw * 4; m < MROWS; m += NGW * 4) rms_rows4_to_bf16(args.in[1] + (size_t)m * 1024, args.in[12], MEMN + (size_t)m * 512, lane, nullptr, true);
        __syncthreads();
    }
    SEAM(0);
    if (IN(1)) {
        { pg8::Gemm g{A, WIN, nullptr, T_, NPROJ, 1024}; pg8::StaticOrder S; S.init(T_, NPROJ, G, (int)blockIdx.x, WGM_P1);
          pg8::EpiBf16P E{PROJ, NPROJ, 0};
          pg8::gemm_phase<pg8::EpiBf16P, pg8::StaticOrder, true, false>(lds + RING_OFF, g, S, E); }
        { constexpr int tMem = (int)(WS_MEMN / (256 * 1024)), tW = (int)(WS_WXKV / (256 * 1024));
          pg8::Gemm g{(const bf16*)ws, (const bf16*)ws, nullptr, 0, 0, 1024}; pg8::KvOrder S{G, (int)blockIdx.x, tMem, tW};
          pg8::EpiKV E{KBp, VTp, tMem, tW};
          pg8::gemm_phase<pg8::EpiKV, pg8::KvOrder, true, false, true>(lds + RING_OFF, g, S, E); }
    }
    SEAM(1);
    if (IN(2)) {
        const int sub = args.sub;
        const bf16* WSPb = (const bf16*)(ws + WS_WSP);
        if (sub & 1) {
            const int first = (sub & 6) ? 128 : 0, nb = G - first;
            if ((int)blockIdx.x >= first) for (int u = (int)blockIdx.x - first; u < T_ / 128; u += ((sub & 8) ? 2 * nb : nb)) gmlp_unit(lds, PROJ, WSPb, args.in[4], args.in[6], args.in[7], Y, u);
            if ((int)blockIdx.x >= first && (sub & 3) == 3 && !(sub & 0x3c)) {
                LAS float* scr = (LAS float*)(lds + RING_OFF + wave * 16384);
                constexpr int I_E = 32 * 256;
                for (int it = ((int)blockIdx.x - first) * NWAVES + wave; it < (TAIL_GATE ? 3 : 2) * I_E; it += nb * NWAVES) {
                    if (it >= 2 * I_E) { const int r = it - 2 * I_E, e = r >> 8, q = r & 255, kb = q >> 4, nbk = q & 15, n0 = 32 * nbk, dest = 256 * (n0 >> 7) + (n0 & 127);
                        p0_transpose_item8(args.in[21] + (size_t)e * 1024 * 512, 1024, 512, (unsigned char*)WGU + (size_t)e * 1024 * 1024, dest - n0, scr, kb, nbk, lane, 64.0f); }
                    else if (it < I_E) { const int e = it >> 8, q = it & 255, kb = q >> 4, nbk = q & 15, n0 = 32 * nbk, dest = 256 * (n0 >> 7) + (n0 & 127) + 128;
                        p0_transpose_item8(args.in[22] + (size_t)e * 1024 * 512, 1024, 512, (unsigned char*)WGU + (size_t)e * 1024 * 1024, dest - n0, scr, kb, nbk, lane, 64.0f); }
                    else { const int r = it - I_E, e = r >> 8, q = r & 255, kb = q >> 5, nbk = q & 31;
                        p0_transpose_item8(args.in[23] + (size_t)e * 512 * 1024, 512, 1024, (unsigned char*)WDN + (size_t)e * 1024 * 512, 0, scr, kb, nbk, lane, 32.0f); } }
            }
        }
        if ((sub & 2) && ((int)blockIdx.x < 128 || (sub & 32))) hgrn_seq2(lds, PROJ, args.in[8], args.in[9], Y, (int)blockIdx.x & 127, (sub & 16) ? 16 : S_ / 64);
    }
    SEAM(2);
    if (IN(3)) {
        pg8::Gemm g{Y, WOUT, nullptr, T_, 1024, 1024}; pg8::StaticOrder S; S.init(T_, 1024, G, (int)blockIdx.x, WGM_N1K);
        pg8::EpiResBf16Ssq E{invrs, invg, A, ssq1, H1F8};
        pg8::gemm_phase<pg8::EpiResBf16Ssq, pg8::StaticOrder, true, false>(lds + RING_OFF, g, S, E);
    }
    SEAM(3);
    if (IN(5)) {
        pg8::Gemm g{(const bf16*)H1F8, WXQ, nullptr, T_, 1024, 1024}; pg8::StaticOrder S; S.init(T_, 1024, G, (int)blockIdx.x, WGM_N1K);
        pg8::EpiBf16RowScale E{Y, ssq1, 1024, EPS, 1.0f / 64.0f, 0};
        pg8::gemm_phase<pg8::EpiBf16RowScale, pg8::StaticOrder, true, false, true>(lds + RING_OFF, g, S, E);
    }
    SEAM(5);
    if (IN(6)) attn_phase(lds + RING_OFF, Y, KBp, VTp, O8, G);
    SEAM(6);
    if (IN(7)) {
        pg8::Gemm g{(const bf16*)O8, WXO, nullptr, T_, 1024, 1024}; pg8::StaticOrder S; S.init(T_, 1024, G, (int)blockIdx.x, WGM_N1K);
        pg8::EpiResBf16InPlace E{A, A, (unsigned char*)Y, args.in[16], ssq1, 1.0f / 64.0f, 0};
        pg8::gemm_phase<pg8::EpiResBf16InPlace, pg8::StaticOrder, true, false, true>(lds + RING_OFF, g, S, E);
    }
    SEAM(7);
    if (IN(8)) {
        typedef short bf16x8 __attribute__((ext_vector_type(8)));
        LAS float* lg = (LAS float*)(lds + wave * 6144);
        LAS int* hh = (LAS int*)(lds + 65536);
        const float* gain = args.in[16];
        for (int blk = blockIdx.x; blk < T_ / 256; blk += G) {
            if (tid < 32) hh[tid] = 0;
            __syncthreads();
            const int t0 = blk * 256 + wave * 32, fr = lane & 15, fq = lane >> 4;
            f32x4 acc[2][3];
#pragma unroll
            for (int mt = 0; mt < 2; ++mt)
#pragma unroll
                for (int nt = 0; nt < 3; ++nt) acc[mt][nt] = (f32x4){0.f, 0.f, 0.f, 0.f};
            const bf16* hrow = A + (size_t)(t0 + fr) * 1024 + 8 * fq;
            bf16x8 ra[4][2], rb[4][6];
#define P8_LD(st, ks_) do { _Pragma("unroll") for (int mt = 0; mt < 2; ++mt) ra[st][mt] = *(const bf16x8*)(hrow + (size_t)mt * 16 * 1024 + 32 * (ks_)); \
                _Pragma("unroll") for (int q = 0; q < 6; ++q) rb[st][q] = *(const bf16x8*)(WRF + ((size_t)((ks_) * 6 + q) * 64 + lane) * 8); } while (0)
            P8_LD(0, 0); P8_LD(1, 1); P8_LD(2, 2); P8_LD(3, 3);
#pragma unroll 1
            for (int k4 = 0; k4 < 32; k4 += 4) {
#pragma unroll
                for (int st = 0; st < 4; ++st) {
#pragma unroll
                    for (int nt = 0; nt < 3; ++nt)
#pragma unroll
                        for (int mt = 0; mt < 2; ++mt) {
                            acc[mt][nt] = __builtin_amdgcn_mfma_f32_16x16x32_bf16(ra[st][mt], rb[st][2 * nt], acc[mt][nt], 0, 0, 0);
                            acc[mt][nt] = __builtin_amdgcn_mfma_f32_16x16x32_bf16(ra[st][mt], rb[st][2 * nt + 1], acc[mt][nt], 0, 0, 0);
                        }
                    __builtin_amdgcn_sched_barrier(0);
                    if (k4 + 4 < 32) P8_LD(st, k4 + 4 + st);
                    __builtin_amdgcn_sched_barrier(0);
                }
            }
#undef P8_LD
            float rsv[2];
#pragma unroll
            for (int mt = 0; mt < 2; ++mt) { const f32x4* sp = (const f32x4*)(ssq1 + (size_t)(t0 + 16 * mt + fr) * 16); const f32x4 p0 = sp[0], p1 = sp[1], p2 = sp[2], p3 = sp[3];
                const float s = (((p0.x + p0.y) + (p0.z + p0.w)) + ((p1.x + p1.y) + (p1.z + p1.w))) + (((p2.x + p2.y) + (p2.z + p2.w)) + ((p3.x + p3.y) + (p3.z + p3.w))); rsv[mt] = 1.0f / sqrtf(s * (1.f / 1024.f) + EPS); }
#pragma unroll
            for (int mt = 0; mt < 2; ++mt)
#pragma unroll
                for (int nt = 0; nt < 3; ++nt)
#pragma unroll
                    for (int r = 0; r < 4; ++r) lg[(16 * mt + 4 * fq + r) * 48 + 16 * nt + fr] = acc[mt][nt][r];
            const float myrs = (lane & 16) ? rsv[1] : rsv[0];
            LDS_WAIT(); asm volatile("" ::: "memory");
            if (lane < 32) {
                const int t = t0 + lane; const LAS float* lr = lg + lane * 48;
                float gl[4], el[32];
#pragma unroll
                for (int o = 0; o < 4; ++o) gl[o] = lr[o] * myrs + args.in[18][o];
#pragma unroll
                for (int o = 0; o < 32; ++o) el[o] = lr[4 + o] * myrs + args.in[20][o];
                int gs = 0; float gm = gl[0];
#pragma unroll
                for (int o = 1; o < 4; ++o) if (gl[o] > gm) { gm = gl[o]; gs = o; }
                float gsum = 0.f;
#pragma unroll
                for (int o = 0; o < 4; ++o) gsum += expf(gl[o] - gm);
                const float ggate = 1.0f / gsum;
                float ev[8];
#pragma unroll
                for (int i = 0; i < 8; ++i) { float v = el[i];
#pragma unroll
                    for (int g2 = 1; g2 < 4; ++g2) v = (gs == g2) ? el[g2 * 8 + i] : v; ev[i] = v; }
                int i0 = 0; float v0 = ev[0];
#pragma unroll
                for (int i = 1; i < 8; ++i) if (ev[i] > v0) { v0 = ev[i]; i0 = i; }
                int i1 = -1; float v1 = -3.0e38f;
#pragma unroll
                for (int i = 0; i < 8; ++i) if (i != i0 && ev[i] > v1) { v1 = ev[i]; i1 = i; }
                if (i1 < 0) i1 = (i0 + 1) & 7;
                const float p0 = 1.0f / (1.0f + expf(v1 - v0)), p1 = 1.0f - p0;
                const int e0 = gs * 8 + i0, e1 = gs * 8 + i1;
                rs[t] = myrs; tok_e[t * 2] = e0; tok_e[t * 2 + 1] = e1; tok_g[t * 2] = p0 * ggate; tok_g[t * 2 + 1] = p1 * ggate;
                lpos[t * 2] = __hip_atomic_fetch_add((int*)(hh + e0), 1, __ATOMIC_RELAXED, __HIP_MEMORY_SCOPE_WORKGROUP); lpos[t * 2 + 1] = __hip_atomic_fetch_add((int*)(hh + e1), 1, __ATOMIC_RELAXED, __HIP_MEMORY_SCOPE_WORKGROUP);
            }
            __syncthreads();
            if (tid < 32) hist[blk * 32 + tid] = hh[tid];
            __syncthreads();
        }
        if (blockIdx.x == 0 && tid < 256) ((unsigned*)((unsigned char*)Y + (size_t)T_ * 1024))[tid] = 0u;
    }
    SEAM(8);
    if (IN(9)) {
        LAS int* sh = (LAS int*)lds;
        for (int blk = blockIdx.x; blk < T_ / 256; blk += G) {
            { const int e = tid & 31, p = tid >> 5; int s = 0, sp = 0;
              for (int b = 16 * p; b < 16 * p + 16; ++b) { const int h = hist[b * 32 + e]; s += h; sp += (b < blk) ? h : 0; }
              sh[128 + p * 32 + e] = s; sh[640 + p * 32 + e] = sp; }
            __syncthreads();
            if (tid < 32) { int s = 0, sp = 0; for (int p = 0; p < 16; ++p) { s += sh[128 + p * 32 + tid]; sp += sh[640 + p * 32 + tid]; } sh[tid] = s; sh[32 + tid] = sp; }
            __syncthreads();
            if (tid == 0) { int run = 0; for (int e = 0; e < 32; ++e) { sh[64 + e] = run; run += (sh[e] + EBLK - 1) / EBLK * EBLK; } sh[96] = run; }
            __syncthreads();
            { const int t = blk * 256 + (tid >> 1), k = tid & 1, e = tok_e[t * 2 + k]; const int slot = sh[64 + e] + sh[32 + e] + lpos[t * 2 + k];
              slot_tok[slot] = t; slot_gate[slot] = tok_g[t * 2 + k]; slot_rs[slot] = rs[t]; tok_slot[t * 2 + k] = slot; }
            if (blk < 32) for (int s = sh[64 + blk] + sh[blk] + tid; s < sh[64 + blk + 1]; s += 512) { slot_tok[s] = T_; slot_gate[s] = 0.f; slot_rs[s] = 0.f; }
            if (blk == 0) {
                if (tid < 33) small[SM_PADSTART + tid] = sh[64 + tid];
                for (int b = tid; b < NBLK; b += 512) { const int st = b * EBLK; int e = -1; for (int j = 0; j < 32; ++j) if (st >= sh[64 + j] && st < sh[64 + j + 1]) e = j; small[SM_BLOCKE + b] = e; }
            }
            __syncthreads();
        }
    }
    SEAM(9);
    if (IN(10)) {
        const int nblk_used = small[SM_PADSTART + 32] / EBLK;
        pg8::Gemm g{Y, WGU, slot_tok, 0, 0, 1024}; pg8::MoeOrder S; S.init(nblk_used, G, (int)blockIdx.x, small + SM_BLOCKE, WGM_MOE);
        pg8::EpiMoe1F8 E{(unsigned char*)HID, slot_rs};
        pg8::gemm_phase<pg8::EpiMoe1F8, pg8::MoeOrder, true, true, true>(lds + RING_OFF, g, S, E);
    }
    SEAM(10);
    if (IN(11)) {
        const int nblk_used = small[SM_PADSTART + 32] / EBLK;
        pg8::Gemm g{HID, WDN, nullptr, 0, 0, 512}; pg8::MoeOrder S; S.init(nblk_used, G, (int)blockIdx.x, small + SM_BLOCKE, WGM_MOE);
        pg8::EpiMoe2 E{(unsigned char*)YB, slot_gate, 1.0f / 32.0f, 0};
        pg8::gemm_phase<pg8::EpiMoe2, pg8::MoeOrder, true, false, true>(lds + RING_OFF, g, S, E);
    }
    SEAM(11);
    if (IN(12)) {
        const float* gain = args.in[24];
        f32x4 gfin[4];
#pragma unroll
        for (int j = 0; j < 4; ++j) gfin[j] = ((const GAS f32x4*)gain)[lane + 64 * j];
        for (int m0 = gw * 4; m0 < T_; m0 += NGW * 4) {
            f32x4 v[4][4]; unsigned ya[4][4], yc[4][4];
#pragma unroll
            for (int r = 0; r < 4; ++r) { const int m = m0 + r; const int s0 = tok_slot[m * 2], s1 = tok_slot[m * 2 + 1];
                const GAS unsigned long long* xr = (const GAS unsigned long long*)(A + (size_t)m * 1024) + lane;
                const GAS unsigned* y0 = (const GAS unsigned*)((const unsigned char*)YB + (size_t)s0 * 1024) + lane; const GAS unsigned* y1 = (const GAS unsigned*)((const unsigned char*)YB + (size_t)s1 * 1024) + lane;
#pragma unroll
                for (int j = 0; j < 4; ++j) { const unsigned long long hb = xr[64 * j]; v[r][j] = (f32x4){__uint_as_float((unsigned)hb << 16), __uint_as_float((unsigned)hb & 0xffff0000u), __uint_as_float((unsigned)(hb >> 32) << 16), __uint_as_float((unsigned)(hb >> 32) & 0xffff0000u)}; ya[r][j] = y0[64 * j]; yc[r][j] = y1[64 * j]; } }
#pragma unroll
            for (int r = 0; r < 4; ++r) { float s = 0.f;
#pragma unroll
                for (int j = 0; j < 4; ++j) { const unsigned a = ya[r][j], c = yc[r][j];
                    v[r][j].x += (__builtin_amdgcn_cvt_f32_fp8((int)a, 0) + __builtin_amdgcn_cvt_f32_fp8((int)c, 0)) * 0.0625f; v[r][j].y += (__builtin_amdgcn_cvt_f32_fp8((int)a, 1) + __builtin_amdgcn_cvt_f32_fp8((int)c, 1)) * 0.0625f;
                    v[r][j].z += (__builtin_amdgcn_cvt_f32_fp8((int)a, 2) + __builtin_amdgcn_cvt_f32_fp8((int)c, 2)) * 0.0625f; v[r][j].w += (__builtin_amdgcn_cvt_f32_fp8((int)a, 3) + __builtin_amdgcn_cvt_f32_fp8((int)c, 3)) * 0.0625f;
                    s += (v[r][j].x * v[r][j].x + v[r][j].y * v[r][j].y) + (v[r][j].z * v[r][j].z + v[r][j].w * v[r][j].w); }
                const float rr = 1.0f / sqrtf(wave_sum_dpp(s) * (1.f / 1024.f) + EPS);
                GAS f32x4* xw = (GAS f32x4*)(out + (size_t)(m0 + r) * 1024) + lane;
#pragma unroll
                for (int j = 0; j < 4; ++j) { const f32x4 g = gfin[j]; xw[64 * j] = (f32x4){v[r][j].x * rr * g.x, v[r][j].y * rr * g.y, v[r][j].z * rr * g.z, v[r][j].w * rr * g.w}; } }
        }
    }
#undef IN
#undef SEAM
}
#ifndef FAST_MASK
#define FAST_MASK 0xFFFF
#endif
extern "C" void kernel_launch(void* const* d_in, const int* in_sizes, int n_in, void* d_out, int out_size, void* d_ws, size_t ws_size, hipStream_t stream) {
    if (n_in != 25 || out_size != T_ * D_ || ws_size < WS_END) { fprintf(stderr, "kernel_launch: unexpected shapes n_in %d out %d ws %zu\n", n_in, out_size, ws_size); return; }
    static int grid = 0;
    if (grid == 0) {
        int dev = 0, cus = 0;
        if (hipGetDevice(&dev) != hipSuccess || hipDeviceGetAttribute(&cus, hipDeviceAttributeMultiprocessorCount, dev) != hipSuccess) { grid = -1; return; }
        if (hipFuncSetAttribute((const void*)mk, hipFuncAttributeMaxDynamicSharedMemorySize, LDS_BYTES) != hipSuccess) { fprintf(stderr, "hipFuncSetAttribute failed\n"); grid = -1; return; }
        int per_cu = 0; (void)hipOccupancyMaxActiveBlocksPerMultiprocessor(&per_cu, (const void*)mk, NWAVES * 64, LDS_BYTES); (void)hipGetLastError();
        grid = cus;
    }
    if (grid < 0) return;
    const float* x = (const float*)d_in[0]; const float* mem = (const float*)d_in[1]; const float* norm_mix = (const float*)d_in[2]; const float* w_in = (const float*)d_in[3];
    const float* gmlp_ln = (const float*)d_in[4]; const float* gmlp_w = (const float*)d_in[5]; const float* gmlp_b = (const float*)d_in[6]; const float* gmlp_beta = (const float*)d_in[7];
    const float* lb_logits = (const float*)d_in[8]; const float* out_gain = (const float*)d_in[9]; const float* w_out = (const float*)d_in[10]; const float* norm_xattn = (const float*)d_in[11];
    const float* norm_mem = (const float*)d_in[12]; const float* w_xq = (const float*)d_in[13]; const float* w_xkv = (const float*)d_in[14]; const float* w_xo = (const float*)d_in[15];
    const float* norm_ffn = (const float*)d_in[16]; const float* wrg = (const float*)d_in[17]; const float* brg = (const float*)d_in[18]; const float* wre = (const float*)d_in[19]; const float* bre = (const float*)d_in[20];
    const float* weg = (const float*)d_in[21]; const float* weu = (const float*)d_in[22]; const float* wed = (const float*)d_in[23]; const float* norm_final = (const float*)d_in[24];
    unsigned char* ws = (unsigned char*)d_ws; float* out = (float*)d_out;
    bf16* A = (bf16*)(ws + WS_A); bf16* Y = (bf16*)(ws + WS_Y); bf16* MEMN = (bf16*)(ws + WS_MEMN); bf16* KV = (bf16*)(ws + WS_KVOLD); bf16* PROJ = (bf16*)(ws + WS_PROJ);
    bf16* HID = (bf16*)(ws + WS_HID); bf16* YB = (bf16*)(ws + WS_YB);
    int* tok_e = (int*)(ws + WS_TOKE); float* tok_g = (float*)(ws + WS_TOKG); int* lpos = (int*)(ws + WS_LPOS); int* tok_slot = (int*)(ws + WS_TOKSLOT);
    int* slot_tok = (int*)(ws + WS_SLOTTOK); float* slot_gate = (float*)(ws + WS_SLOTGATE); int* hist = (int*)(ws + WS_HIST); int* base = (int*)(ws + WS_BASE); int* small = (int*)(ws + WS_SMALL); float* rs = (float*)(ws + WS_RS); float* slot_rs = (float*)(ws + WS_SLOTRS);
    float* scr0 = out; float* scr1 = out + (size_t)T_ * 512;

    (void)hipMemsetAsync(ws + WS_CTL, 0, CTL_ZERO_BYTES, stream);
    Args a{};
    for (int i = 0; i < 25; ++i) a.in[i] = (const float*)d_in[i];
    a.out = out; a.ws = ws;
#define FAST(k) ((FAST_MASK >> (k)) & 1)
#ifndef PROBE_K
#define PROBE_K (-1)
#endif
#ifndef PROBE_N
#define PROBE_N 4
#endif
#ifndef PROBE_SUB
#define PROBE_SUB 3
#endif
#define PROBE(k) do { if (PROBE_K == (k)) { if ((k) == 2) a.sub = PROBE_SUB; for (int r_ = 0; r_ < PROBE_N; ++r_) RUN_FAST((k), (k) + 1); } } while (0)
#define RUN_FAST(lo_, hi_) do { a.ph_lo = (lo_); a.ph_hi = (hi_); hipLaunchKernelGGL(mk, dim3(grid), dim3(NWAVES * 64), LDS_BYTES, stream, a); } while (0)
    if (FAST_MASK == 0xFFFF) { a.sub = 3; RUN_FAST(0, 13); return; }
    if (FAST(0)) { RUN_FAST(0, 1); PROBE(0); }
    else { k_rmsnorm1024<<<T_ / 4, 256, 0, stream>>>(x, norm_mix, A, T_, 0); k_rmsnorm1024<<<MROWS / 4, 256, 0, stream>>>(mem, norm_mem, MEMN, MROWS, 0); }
    if (FAST(1)) { RUN_FAST(1, 2); PROBE(1); }
    else { k_gemm_naive<ALPlain, BLPlain, EPBf16, false><<<dim3(NPROJ / 64, T_ / 64), 256, 0, stream>>>(ALPlain{A, 1024, 0}, BLPlain{w_in, NPROJ, 0}, EPBf16{PROJ, NPROJ, 0}, nullptr, nullptr, 1024, 0);
         }
    if (!FAST(6)) k_gemm_naive<ALPlain, BLPlain, EPBf16, false><<<dim3(2048 / 64, MROWS / 64), 256, 0, stream>>>(ALPlain{MEMN, 1024, 0}, BLPlain{w_xkv, 2048, 0}, EPBf16{KV, 2048, 0}, nullptr, nullptr, 1024, 0);
    a.sub = (FAST(2) ? 3 : 0) | FAST(13) | (FAST(14) << 1);
    if (a.sub) { RUN_FAST(2, 3); PROBE(2); }
    if (!(a.sub & 1)) { k_gmlp_ln<<<T_ / 4, 256, 0, stream>>>(PROJ, gmlp_ln, scr0);
           k_gmlp_spatial<<<(unsigned)((size_t)T_ * 512 / 256), 256, 0, stream>>>(PROJ, scr0, gmlp_w, gmlp_b, scr1);
           k_rmsnorm512<<<T_ / 4, 256, 0, stream>>>(scr1, gmlp_beta, Y); }
    if (!(a.sub & 2)) { k_hgrn_rec<<<B_ * 4, 128, 0, stream>>>(PROJ, lb_logits, scr0);
           k_hgrn_out<<<T_ / 4, 256, 0, stream>>>(scr0, PROJ, out_gain, Y); }
    if (FAST(3)) { RUN_FAST(3, 4); PROBE(3); }
    else k_gemm_naive<ALPlain, BLPlain, EPRes, false><<<dim3(1024 / 64, T_ / 64), 256, 0, stream>>>(ALPlain{Y, 1024, 0}, BLPlain{w_out, 1024, 0}, EPRes{x, out, 1024, 0}, nullptr, nullptr, 1024, 0);
    if (!FAST(4)) k_rmsnorm1024<<<T_ / 4, 256, 0, stream>>>(out, norm_xattn, A, T_, 0);
    if (FAST(5)) { RUN_FAST(5, 6); PROBE(5); }
    else k_gemm_naive<ALPlain, BLPlain, EPBf16, false><<<dim3(1024 / 64, T_ / 64), 256, 0, stream>>>(ALPlain{A, 1024, 0}, BLPlain{w_xq, 1024, 0}, EPBf16{Y, 1024, 0}, nullptr, nullptr, 1024, 0);
    if (FAST(6)) { RUN_FAST(6, 7); PROBE(6); }
    else k_attn_naive<<<T_, 256, 0, stream>>>(Y, KV, A);
    if (FAST(7)) RUN_FAST(7, 8);
    else k_gemm_naive<ALPlain, BLPlain, EPRes, false><<<dim3(1024 / 64, T_ / 64), 256, 0, stream>>>(ALPlain{A, 1024, 0}, BLPlain{w_xo, 1024, 0}, EPRes{out, out, 1024, 0}, nullptr, nullptr, 1024, 0);
    if (FAST(8)) { RUN_FAST(8, 9); PROBE(8); }
    else { k_router_naive<<<T_ / 4, 256, 0, stream>>>(out, norm_ffn, wrg, brg, wre, bre, Y, tok_e, tok_g, rs);
           (void)hipMemsetAsync(Y + (size_t)T_ * 1024, 0, 2048, stream);
           k_route_hist<<<256, 256, 0, stream>>>(tok_e, lpos, hist); }
    if (FAST(9)) { RUN_FAST(9, 10); PROBE(9); }
    else { k_route_scan<<<1, 256, 0, stream>>>(hist, base, small);
           k_route_fill<<<256, 256, 0, stream>>>(tok_e, tok_g, lpos, base, small, slot_tok, slot_gate, tok_slot, rs, slot_rs); }
    if (FAST(10)) { RUN_FAST(10, 11); PROBE(10); }
    else k_gemm_naive<ALGather, BLMoe1, EPBf16, true><<<dim3(512 / 32, NSLOT / 64), 256, 0, stream>>>(ALGather{Y, slot_tok, 1024, 0}, BLMoe1{weg, weu, small + SM_BLOCKE}, EPBf16{nullptr, 0, 0}, HID, slot_rs, 1024, 0);
    if (FAST(11)) { RUN_FAST(11, 12); PROBE(11); }
    else k_gemm_naive<ALPlain, BLMoe2, EPScale, false><<<dim3(1024 / 64, NSLOT / 64), 256, 0, stream>>>(ALPlain{HID, 512, 0}, BLMoe2{wed, small + SM_BLOCKE}, EPScale{YB, slot_gate, 1024, 0}, nullptr, nullptr, 512, 0);
    if (FAST(12)) RUN_FAST(12, 13);
    else k_final<<<T_ / 4, 256, 0, stream>>>(out, YB, tok_slot, norm_final);
}
```

```cpp
#define FAST_MASK 0xFFFF
#include <hip/hip_runtime.h>
#include <stdint.h>
#include <stdio.h>

typedef unsigned short bf16;
constexpr int B_ = 32, S_ = 2048, D_ = 1024, T_ = B_ * S_;
constexpr int NPROJ = 3072, DG = 512, DH = 512, NMEM = 256, MROWS = B_ * NMEM;
constexpr int NE = 32, DEXP = 512, EBLK = 256, NSLOT = 2 * T_ + NE * EBLK, NBLK = NSLOT / EBLK;
constexpr float EPS = 1e-6f;

constexpr size_t MiB = 1u << 20;
constexpr size_t WS_CTL = 0;
constexpr size_t WS_TOKE = 1 * MiB, WS_TOKG = WS_TOKE + 512 * 1024, WS_LPOS = WS_TOKG + 512 * 1024, WS_TOKSLOT = WS_LPOS + 512 * 1024;
constexpr size_t WS_SLOTTOK = 3 * MiB, WS_SLOTGATE = 4 * MiB, WS_HIST = 5 * MiB, WS_BASE = WS_HIST + 64 * 1024, WS_SMALL = WS_BASE + 64 * 1024;
constexpr size_t WS_SSQ1 = 15 * MiB + 512 * 1024;
constexpr size_t WS_INVRS = 15 * MiB + 512 * 1024;
constexpr size_t WS_WSP = 15 * MiB;
constexpr size_t WS_WRF = 12 * MiB, WS_RS = 13 * MiB, WS_SLOTRS = 14 * MiB;
constexpr size_t WS_WIN = 16 * MiB, WS_WOUT = 22 * MiB, WS_WXQ = 24 * MiB, WS_WXKV = 26 * MiB, WS_WXO = 30 * MiB, WS_WGU = 32 * MiB, WS_WDN = 96 * MiB;
constexpr size_t WS_A = 128 * MiB, WS_Y = 256 * MiB, WS_MEMN = 386 * MiB, WS_KV = 402 * MiB, WS_PROJ = 434 * MiB;
constexpr size_t WS_HID = WS_PROJ, WS_YB = WS_PROJ + 136 * MiB, WS_KVOLD = 850 * MiB, WS_END = 882 * MiB;
constexpr size_t WS_KB = WS_KV, WS_VT = WS_KV + 16 * MiB;
constexpr int SM_PADSTART = 0, SM_CNTEND = 64, SM_BLOCKE = 128;

__device__ __forceinline__ float bf2f(bf16 v) { return __uint_as_float(((unsigned)v) << 16); }
__device__ __forceinline__ bf16 f2bf(float f) { unsigned u = __float_as_uint(f); u += 0x7fffu + ((u >> 16) & 1u); return (bf16)(u >> 16); }
__device__ __forceinline__ float wave_sum(float v) {
#pragma unroll
    for (int o = 1; o < 64; o <<= 1) v += __shfl_xor(v, o);
    return v;
}
__device__ __forceinline__ float row16_sum_dpp(float v) {
    v += __int_as_float(__builtin_amdgcn_update_dpp(0, __float_as_int(v), 0xB1, 0xf, 0xf, true));
    v += __int_as_float(__builtin_amdgcn_update_dpp(0, __float_as_int(v), 0x4E, 0xf, 0xf, true));
    v += __int_as_float(__builtin_amdgcn_update_dpp(0, __float_as_int(v), 0x141, 0xf, 0xf, true));
    v += __int_as_float(__builtin_amdgcn_update_dpp(0, __float_as_int(v), 0x140, 0xf, 0xf, true));
    return v;
}
__device__ __forceinline__ float wave_sum_dpp(float v) {
    v = row16_sum_dpp(v);
    const float a = __int_as_float(__builtin_amdgcn_readlane(__float_as_int(v), 0)), b = __int_as_float(__builtin_amdgcn_readlane(__float_as_int(v), 16));
    const float c = __int_as_float(__builtin_amdgcn_readlane(__float_as_int(v), 32)), d = __int_as_float(__builtin_amdgcn_readlane(__float_as_int(v), 48));
    return (a + b) + (c + d);
}
__device__ __forceinline__ float wave_max(float v) {
#pragma unroll
    for (int o = 1; o < 64; o <<= 1) v = fmaxf(v, __shfl_xor(v, o));
    return v;
}
__device__ __forceinline__ float gelu_tanh(float x) { const float u = 0.7978845608028654f * (x + 0.044715f * x * x * x); return 0.5f * x * (1.0f + tanhf(u)); }
__device__ __forceinline__ float sigmoidf_(float x) { return 1.0f / (1.0f + expf(-x)); }
__device__ __forceinline__ float siluf_(float x) { return x / (1.0f + expf(-x)); }

__global__ __launch_bounds__(256) void k_rmsnorm1024(const float* __restrict__ x, const float* __restrict__ gain, bf16* __restrict__ out, int rows, int rpad) {
    const int w = (int)((blockIdx.x * 256u + threadIdx.x) >> 6), lane = threadIdx.x & 63;
    if (w >= rows) return;
    const float4* xr = (const float4*)(x + (size_t)w * 1024);
    float4 v[4]; float s = 0.f;
#pragma unroll
    for (int j = 0; j < 4; ++j) { v[j] = xr[lane + 64 * j]; s += v[j].x * v[j].x + v[j].y * v[j].y + v[j].z * v[j].z + v[j].w * v[j].w; }
    s = wave_sum(s);
    const float r = 1.0f / sqrtf(s * (1.0f / 1024.0f) + EPS);
#pragma unroll
    for (int j = 0; j < 4; ++j) {
        const float4 g = ((const float4*)gain)[lane + 64 * j];
        ushort4 o; o.x = f2bf(v[j].x * r * g.x); o.y = f2bf(v[j].y * r * g.y); o.z = f2bf(v[j].z * r * g.z); o.w = f2bf(v[j].w * r * g.w);
        ((ushort4*)(out + (size_t)w * 1024))[lane + 64 * j] = o;
    }
}

struct ALPlain { const bf16* A; int lda; int pad; __device__ const bf16* row(int r) const { return A + (size_t)r * lda; } };
struct ALGather { const bf16* A; const int* idx; int lda; int pad; __device__ const bf16* row(int r) const { return A + (size_t)idx[r] * lda; } };
struct BLPlain { const float* W; int ldb; int pad; __device__ bool valid(int) const { return true; }
    __device__ float4 ld(int  , int k, int n0, int c4) const { return *(const float4*)(W + (size_t)k * ldb + n0 + c4); } };
struct BLMoe1 { const float* Wg; const float* Wu; const int* block_e;
    __device__ bool valid(int tm) const { return block_e[tm >> 2] >= 0; }
    __device__ float4 ld(int tm, int k, int n0  , int c4) const { const int e = block_e[tm >> 2]; const int tn = n0 >> 6; const float* W = (c4 < 32) ? Wg : Wu; const int c = 32 * tn + (c4 & 31);
        return *(const float4*)(W + ((size_t)e * 1024 + k) * 512 + c); } };
struct BLMoe2 { const float* Wd; const int* block_e;
    __device__ bool valid(int tm) const { return block_e[tm >> 2] >= 0; }
    __device__ float4 ld(int tm, int k, int n0, int c4) const { const int e = block_e[tm >> 2]; return *(const float4*)(Wd + ((size_t)e * 512 + k) * 1024 + n0 + c4); } };
struct EPBf16 { bf16* O; int ldc; int pad; __device__ void st(int r, int c, const float (&a)[4]) const { ushort4 o; o.x = f2bf(a[0]); o.y = f2bf(a[1]); o.z = f2bf(a[2]); o.w = f2bf(a[3]); *(ushort4*)(O + (size_t)r * ldc + c) = o; } };
struct EPRes { const float* R; float* O; int ldc; int pad; __device__ void st(int r, int c, const float (&a)[4]) const { const float4 b = *(const float4*)(R + (size_t)r * ldc + c); *(float4*)(O + (size_t)r * ldc + c) = make_float4(b.x + a[0], b.y + a[1], b.z + a[2], b.w + a[3]); } };
struct EPScale { bf16* O; const float* sc; int ldc; int pad; __device__ void st(int r, int c, const float (&a)[4]) const { const float s = sc[r]; ushort4 o; o.x = f2bf(a[0] * s); o.y = f2bf(a[1] * s); o.z = f2bf(a[2] * s); o.w = f2bf(a[3] * s); *(ushort4*)(O + (size_t)r * ldc + c) = o; } };

template <class AL, class BL, class EP, bool MOE1>
__global__ __launch_bounds__(256) void k_gemm_naive(AL al, BL bl, EP ep, bf16* hid, const float* rsl, int K, int kpad) {
    __shared__ float As[16][68];
    __shared__ float Bs[16][64];
    const int tid = threadIdx.x, tx = tid & 15, ty = tid >> 4, tm = blockIdx.y, tn = blockIdx.x;
    if (!bl.valid(tm)) return;
    float acc[4][4];
#pragma unroll
    for (int i = 0; i < 4; ++i)
#pragma unroll
        for (int j = 0; j < 4; ++j) acc[i][j] = 0.f;
    const int ar = tid >> 2, ak = (tid & 3) * 4;
    const int bk = tid >> 4, bc = (tid & 15) * 4;
    const bf16* arow = al.row(tm * 64 + ar);
    int cc[4];
#pragma unroll
    for (int j = 0; j < 4; ++j) cc[j] = MOE1 ? ((j < 2) ? 2 * tx + j : 32 + 2 * tx + (j - 2)) : 4 * tx + j;
    for (int k0 = 0; k0 < K; k0 += 16) {
        const ushort4 av = *(const ushort4*)(arow + k0 + ak);
        const float4 bv = bl.ld(tm, k0 + bk, tn * 64, bc);
        __syncthreads();
        As[ak + 0][ar] = bf2f(av.x); As[ak + 1][ar] = bf2f(av.y); As[ak + 2][ar] = bf2f(av.z); As[ak + 3][ar] = bf2f(av.w);
        *(float4*)&Bs[bk][bc] = bv;
        __syncthreads();
#pragma unroll
        for (int k = 0; k < 16; ++k) {
            const float4 a4 = *(const float4*)&As[k][ty * 4];
            const float a[4] = {a4.x, a4.y, a4.z, a4.w};
            float b[4];
#pragma unroll
            for (int j = 0; j < 4; ++j) b[j] = Bs[k][cc[j]];
#pragma unroll
            for (int i = 0; i < 4; ++i)
#pragma unroll
                for (int j = 0; j < 4; ++j) acc[i][j] += a[i] * b[j];
        }
    }
#pragma unroll
    for (int i = 0; i < 4; ++i) {
        const int r = tm * 64 + ty * 4 + i;
        if (MOE1) {
            const float sc = rsl[r]; const float h0 = siluf_(acc[i][0] * sc) * (acc[i][2] * sc), h1 = siluf_(acc[i][1] * sc) * (acc[i][3] * sc);
            ushort2 o; o.x = f2bf(h0); o.y = f2bf(h1);
            *(ushort2*)(hid + (size_t)r * 512 + tn * 32 + 2 * tx) = o;
        } else ep.st(r, tn * 64 + 4 * tx, acc[i]);
    }
}

__global__ __launch_bounds__(256) void k_gmlp_ln(const bf16* __restrict__ proj, const float* __restrict__ ln_gain, float* __restrict__ vln) {
    const int w = (int)((blockIdx.x * 256u + threadIdx.x) >> 6), lane = threadIdx.x & 63;
    const bf16* p = proj + (size_t)w * NPROJ + 512 + lane * 8;
    const uint4 raw = *(const uint4*)p; const unsigned rw[4] = {raw.x, raw.y, raw.z, raw.w};
    float g[8]; float s = 0.f;
#pragma unroll
    for (int i = 0; i < 4; ++i) { g[2 * i] = gelu_tanh(bf2f((bf16)(rw[i] & 0xffff))); g[2 * i + 1] = gelu_tanh(bf2f((bf16)(rw[i] >> 16))); s += g[2 * i] + g[2 * i + 1]; }
    const float mean = wave_sum(s) * (1.0f / 512.0f); float q = 0.f;
#pragma unroll
    for (int i = 0; i < 8; ++i) { g[i] -= mean; q += g[i] * g[i]; }
    const float rstd = 1.0f / sqrtf(wave_sum(q) * (1.0f / 512.0f) + EPS);
#pragma unroll
    for (int i = 0; i < 8; ++i) vln[(size_t)w * 512 + lane * 8 + i] = g[i] * rstd * ln_gain[lane * 8 + i];
}
__global__ __launch_bounds__(256) void k_gmlp_spatial(const bf16* __restrict__ proj, const float* __restrict__ vln, const float* __restrict__ Wsp, const float* __restrict__ bsp, float* __restrict__ ya) {
    const size_t gid = (size_t)blockIdx.x * 256 + threadIdx.x; const int t = (int)(gid >> 9), ch = (int)(gid & 511), g = ch >> 7, tt = t & 127, base = t - tt;
    const float* wrow = Wsp + ((size_t)g * 128 + tt) * 128;
    float z = bsp[g * 128 + tt];
    for (int s = 0; s <= tt; ++s) z += wrow[s] * vln[(size_t)(base + s) * 512 + ch];
    const float u = gelu_tanh(bf2f(proj[(size_t)t * NPROJ + ch]));
    ya[(size_t)t * 512 + ch] = u * z;
}
__global__ __launch_bounds__(256) void k_rmsnorm512(const float* __restrict__ ya, const float* __restrict__ beta, bf16* __restrict__ y) {
    const int w = (int)((blockIdx.x * 256u + threadIdx.x) >> 6), lane = threadIdx.x & 63;
    float v[8]; float s = 0.f;
#pragma unroll
    for (int i = 0; i < 8; ++i) { v[i] = ya[(size_t)w * 512 + lane * 8 + i]; s += v[i] * v[i]; }
    const float r = 1.0f / sqrtf(wave_sum(s) * (1.0f / 512.0f) + EPS);
#pragma unroll
    for (int i = 0; i < 8; ++i) y[(size_t)w * 1024 + lane * 8 + i] = f2bf(v[i] * r * beta[lane * 8 + i]);
}
__global__ __launch_bounds__(128) void k_hgrn_rec(const bf16* __restrict__ proj, const float* __restrict__ lb_logits, float* __restrict__ o) {
    __shared__ float sq[16][128], sf[16][128], sk[16][128];
    const int b = blockIdx.x >> 2, h = blockIdx.x & 3, tid = threadIdx.x;
    const float l0 = lb_logits[h * 128 + tid], l1 = lb_logits[512 + h * 128 + tid];
    const float mx = fmaxf(l0, l1), e0 = expf(l0 - mx), e1 = expf(l1 - mx), lb = e0 / (e0 + e1);
    float S[128];
#pragma unroll
    for (int d = 0; d < 128; ++d) S[d] = 0.f;
    for (int t0 = 0; t0 < S_; t0 += 16) {
        __syncthreads();
        for (int i = 0; i < 16; ++i) {
            const size_t row = (size_t)b * S_ + t0 + i;
            const float ql = bf2f(proj[row * NPROJ + 1024 + h * 128 + tid]), fl = bf2f(proj[row * NPROJ + 1536 + h * 128 + tid]);
            const float f = lb + (1.0f - lb) * sigmoidf_(fl);
            sq[i][tid] = siluf_(ql); sf[i][tid] = f; sk[i][tid] = 1.0f - f;
        }
        __syncthreads();
        for (int i = 0; i < 16; ++i) {
            const size_t row = (size_t)b * S_ + t0 + i;
            const float vv = bf2f(proj[row * NPROJ + 2048 + h * 128 + tid]);
            float acc = 0.f;
#pragma unroll
            for (int d = 0; d < 128; ++d) { S[d] = sf[i][d] * S[d] + sk[i][d] * vv; acc += S[d] * sq[i][d]; }
            o[row * 512 + h * 128 + tid] = acc;
        }
    }
}
__global__ __launch_bounds__(256) void k_hgrn_out(const float* __restrict__ o, const bf16* __restrict__ proj, const float* __restrict__ out_gain, bf16* __restrict__ y) {
    const int w = (int)((blockIdx.x * 256u + threadIdx.x) >> 6), lane = threadIdx.x & 63;
    float v[8]; float s = 0.f;
#pragma unroll
    for (int i = 0; i < 8; ++i) { v[i] = o[(size_t)w * 512 + lane * 8 + i]; s += v[i] * v[i]; }
    s += __shfl_xor(s, 1); s += __shfl_xor(s, 2); s += __shfl_xor(s, 4); s += __shfl_xor(s, 8);
    const float r = 1.0f / sqrtf(s * (1.0f / 128.0f) + EPS);
#pragma unroll
    for (int i = 0; i < 8; ++i) { const int ch = lane * 8 + i; const float g = bf2f(proj[(size_t)w * NPROJ + 2560 + ch]);
        y[(size_t)w * 1024 + 512 + ch] = f2bf(v[i] * r * out_gain[ch] * siluf_(g)); }
}
__global__ __launch_bounds__(256) void k_attn_naive(const bf16* __restrict__ q, const bf16* __restrict__ kv, bf16* __restrict__ o) {
    __shared__ float sq[4][256], sp[4][256];
    const int wv = threadIdx.x >> 6, lane = threadIdx.x & 63; const int w = blockIdx.x * 4 + wv; const int t = w >> 2, h = w & 3, b = t / S_;
#pragma unroll
    for (int j = 0; j < 4; ++j) sq[wv][lane + 64 * j] = bf2f(q[(size_t)t * 1024 + h * 256 + lane + 64 * j]);
    __syncthreads();
    float sc[4]; float mx = -1e30f;
#pragma unroll
    for (int j = 0; j < 4; ++j) {
        const int m = lane + 64 * j; const bf16* kr = kv + (size_t)(b * NMEM + m) * 2048 + h * 256; float s = 0.f;
        for (int d = 0; d < 256; d += 8) { const uint4 raw = *(const uint4*)(kr + d); const unsigned rw[4] = {raw.x, raw.y, raw.z, raw.w};
#pragma unroll
            for (int i = 0; i < 4; ++i) s += sq[wv][d + 2 * i] * bf2f((bf16)(rw[i] & 0xffff)) + sq[wv][d + 2 * i + 1] * bf2f((bf16)(rw[i] >> 16)); }
        sc[j] = s * 0.0625f; mx = fmaxf(mx, sc[j]);
    }
    mx = wave_max(mx); float sum = 0.f;
#pragma unroll
    for (int j = 0; j < 4; ++j) { sc[j] = expf(sc[j] - mx); sum += sc[j]; }
    sum = wave_sum(sum); const float inv = 1.0f / sum;
#pragma unroll
    for (int j = 0; j < 4; ++j) sp[wv][lane + 64 * j] = sc[j] * inv;
    __syncthreads();
    float acc[4] = {0.f, 0.f, 0.f, 0.f};
    for (int m = 0; m < NMEM; ++m) { const float p = sp[wv][m]; const bf16* vr = kv + (size_t)(b * NMEM + m) * 2048 + 1024 + h * 256;
#pragma unroll
        for (int j = 0; j < 4; ++j) acc[j] += p * bf2f(vr[lane + 64 * j]); }
#pragma unroll
    for (int j = 0; j < 4; ++j) o[(size_t)t * 1024 + h * 256 + lane + 64 * j] = f2bf(acc[j]);
}
__global__ __launch_bounds__(256) void k_router_naive(const float* __restrict__ h2, const float* __restrict__ gain, const float* __restrict__ wrg, const float* __restrict__ brg,
                                                       const float* __restrict__ wre, const float* __restrict__ bre, bf16* __restrict__ xn, int* __restrict__ tok_e, float* __restrict__ tok_g, float* __restrict__ rs) {
    const int w = (int)((blockIdx.x * 256u + threadIdx.x) >> 6), lane = threadIdx.x & 63;
    const float4* xr = (const float4*)(h2 + (size_t)w * 1024);
    float x[16]; float s = 0.f;
#pragma unroll
    for (int j = 0; j < 4; ++j) { const float4 v = xr[lane + 64 * j]; x[4 * j] = v.x; x[4 * j + 1] = v.y; x[4 * j + 2] = v.z; x[4 * j + 3] = v.w; s += v.x * v.x + v.y * v.y + v.z * v.z + v.w * v.w; }
    const float r = 1.0f / sqrtf(wave_sum(s) * (1.0f / 1024.0f) + EPS);
#pragma unroll
    for (int j = 0; j < 4; ++j) { const float4 g = ((const float4*)gain)[lane + 64 * j]; ushort4 o; o.x = f2bf(x[4 * j] * g.x); o.y = f2bf(x[4 * j + 1] * g.y); o.z = f2bf(x[4 * j + 2] * g.z); o.w = f2bf(x[4 * j + 3] * g.w); ((ushort4*)(xn + (size_t)w * 1024))[lane + 64 * j] = o;
        x[4 * j] *= r * g.x; x[4 * j + 1] *= r * g.y; x[4 * j + 2] *= r * g.z; x[4 * j + 3] *= r * g.w; }
    float gl[4], el[32];
#pragma unroll
    for (int o = 0; o < 4; ++o) gl[o] = 0.f;
#pragma unroll
    for (int o = 0; o < 32; ++o) el[o] = 0.f;
#pragma unroll
    for (int j = 0; j < 4; ++j)
#pragma unroll
        for (int i = 0; i < 4; ++i) { const int k = (lane + 64 * j) * 4 + i; const float xv = x[4 * j + i];
            const float4 wg = *(const float4*)(wrg + (size_t)k * 4); gl[0] += xv * wg.x; gl[1] += xv * wg.y; gl[2] += xv * wg.z; gl[3] += xv * wg.w;
#pragma unroll
            for (int o4 = 0; o4 < 8; ++o4) { const float4 we = *(const float4*)(wre + (size_t)k * 32 + o4 * 4); el[o4 * 4] += xv * we.x; el[o4 * 4 + 1] += xv * we.y; el[o4 * 4 + 2] += xv * we.z; el[o4 * 4 + 3] += xv * we.w; } }
#pragma unroll
    for (int o = 0; o < 4; ++o) gl[o] = wave_sum(gl[o]) + brg[o];
#pragma unroll
    for (int o = 0; o < 32; ++o) el[o] = wave_sum(el[o]) + bre[o];
    int gs = 0; float gm = gl[0];
#pragma unroll
    for (int o = 1; o < 4; ++o) if (gl[o] > gm) { gm = gl[o]; gs = o; }
    float gsum = 0.f;
#pragma unroll
    for (int o = 0; o < 4; ++o) gsum += expf(gl[o] - gm);
    const float ggate = 1.0f / gsum;
    float ev[8];
#pragma unroll
    for (int i = 0; i < 8; ++i) { float v = el[i];
#pragma unroll
        for (int g2 = 1; g2 < 4; ++g2) v = (gs == g2) ? el[g2 * 8 + i] : v; ev[i] = v; }
    int i0 = 0; float v0 = ev[0];
#pragma unroll
    for (int i = 1; i < 8; ++i) if (ev[i] > v0) { v0 = ev[i]; i0 = i; }
    int i1 = -1; float v1 = -3.0e38f;
#pragma unroll
    for (int i = 0; i < 8; ++i) if (i != i0 && ev[i] > v1) { v1 = ev[i]; i1 = i; }
    const float p0 = 1.0f / (1.0f + expf(v1 - v0)), p1 = 1.0f - p0;
    if (lane == 0) { rs[w] = r; tok_e[w * 2] = gs * 8 + i0; tok_e[w * 2 + 1] = gs * 8 + i1; tok_g[w * 2] = p0 * ggate; tok_g[w * 2 + 1] = p1 * ggate; }
}
__global__ __launch_bounds__(256) void k_route_hist(const int* __restrict__ tok_e, int* __restrict__ lpos, int* __restrict__ hist) {
    __shared__ int h[32];
    const int tid = threadIdx.x, t = blockIdx.x * 256 + tid;
    if (tid < 32) h[tid] = 0;
    __syncthreads();
    lpos[t * 2] = atomicAdd(&h[tok_e[t * 2]], 1); lpos[t * 2 + 1] = atomicAdd(&h[tok_e[t * 2 + 1]], 1);
    __syncthreads();
    if (tid < 32) hist[blockIdx.x * 32 + tid] = h[tid];
}
__global__ __launch_bounds__(256) void k_route_scan(const int* __restrict__ hist, int* __restrict__ base, int* __restrict__ small) {
    __shared__ int tot[32], ps[33];
    const int tid = threadIdx.x;
    if (tid < 32) { int s = 0; for (int b = 0; b < 256; ++b) s += hist[b * 32 + tid]; tot[tid] = s; }
    __syncthreads();
    if (tid == 0) { int run = 0; for (int e = 0; e < 32; ++e) { ps[e] = run; run += (tot[e] + EBLK - 1) / EBLK * EBLK; } ps[32] = run; }
    __syncthreads();
    if (tid < 32) { int run = ps[tid]; for (int b = 0; b < 256; ++b) { base[b * 32 + tid] = run; run += hist[b * 32 + tid]; } small[SM_CNTEND + tid] = run; }
    if (tid < 33) small[SM_PADSTART + tid] = ps[tid];
    for (int blk = tid; blk < NBLK; blk += 256) { const int st = blk * EBLK; int e = -1; for (int j = 0; j < 32; ++j) if (st >= ps[j] && st < ps[j + 1]) e = j; small[SM_BLOCKE + blk] = e; }
}
__global__ __launch_bounds__(256) void k_route_fill(const int* __restrict__ tok_e, const float* __restrict__ tok_g, const int* __restrict__ lpos, const int* __restrict__ base, const int* __restrict__ small,
                                                     int* __restrict__ slot_tok, float* __restrict__ slot_gate, int* __restrict__ tok_slot, const float* __restrict__ rs, float* __restrict__ slot_rs) {
    const int tid = threadIdx.x, t = blockIdx.x * 256 + tid;
#pragma unroll
    for (int k = 0; k < 2; ++k) { const int e = tok_e[t * 2 + k]; const int slot = base[blockIdx.x * 32 + e] + lpos[t * 2 + k]; slot_tok[slot] = t; slot_gate[slot] = tok_g[t * 2 + k]; slot_rs[slot] = rs[t]; tok_slot[t * 2 + k] = slot; }
    if (blockIdx.x < 32) { const int e = blockIdx.x; for (int s = small[SM_CNTEND + e] + tid; s < small[SM_PADSTART + e + 1]; s += 256) { slot_tok[s] = T_; slot_gate[s] = 0.f; slot_rs[s] = 0.f; } }
}
__global__ __launch_bounds__(256) void k_final(float* __restrict__ h2out, const bf16* __restrict__ yb, const int* __restrict__ tok_slot, const float* __restrict__ gain) {
    const int w = (int)((blockIdx.x * 256u + threadIdx.x) >> 6), lane = threadIdx.x & 63;
    const int s0 = tok_slot[w * 2], s1 = tok_slot[w * 2 + 1];
    float4* xr = (float4*)(h2out + (size_t)w * 1024);
    float4 v[4]; float s = 0.f;
#pragma unroll
    for (int j = 0; j < 4; ++j) { v[j] = xr[lane + 64 * j];
        const ushort4 a = ((const ushort4*)(yb + (size_t)s0 * 1024))[lane + 64 * j], c = ((const ushort4*)(yb + (size_t)s1 * 1024))[lane + 64 * j];
        v[j].x += bf2f(a.x) + bf2f(c.x); v[j].y += bf2f(a.y) + bf2f(c.y); v[j].z += bf2f(a.z) + bf2f(c.z); v[j].w += bf2f(a.w) + bf2f(c.w);
        s += v[j].x * v[j].x + v[j].y * v[j].y + v[j].z * v[j].z + v[j].w * v[j].w; }
    const float r = 1.0f / sqrtf(wave_sum(s) * (1.0f / 1024.0f) + EPS);
#pragma unroll
    for (int j = 0; j < 4; ++j) { const float4 g = ((const float4*)gain)[lane + 64 * j]; xr[lane + 64 * j] = make_float4(v[j].x * r * g.x, v[j].y * r * g.y, v[j].z * r * g.z, v[j].w * r * g.w); }
}

#include <type_traits>
namespace pg8 {
#define PG8_LAS __attribute__((address_space(3)))
typedef unsigned short bf16_t;
typedef short bf16x8 __attribute__((ext_vector_type(8)));
typedef float f32x4 __attribute__((ext_vector_type(4)));
typedef unsigned u32x4 __attribute__((ext_vector_type(4)));
constexpr int BM = 256, BK = 64, HALF = 128, HTB = HALF * BK * 2  , STAGE_BYTES = 8 * HTB, NXCD = 8, WGM = 8;

__host__ __device__ __forceinline__ int lds_byte(int r, int c) { const int st = (r >> 4) * 2 + (c >> 5), rr = r & 15, cc = c & 31, ob = rr * 64 + cc * 2; return st * 1024 + (ob ^ (((ob >> 9) & 1) << 5)); }
__host__ __device__ __forceinline__ void stage_rc(int b, int& R, int& C) { const int st = b / 1024, sb = b % 1024, swz = sb ^ (((sb >> 9) & 1) << 5); R = (st >> 1) * 16 + swz / 64; C = (st & 1) * 32 + (swz % 64) / 2; }
__host__ __device__ __forceinline__ int perm32(int rho) { const int n = rho >> 4, i = rho & 15; return 8 * (i >> 2) + 4 * n + (i & 3); }

struct Unit { int pm, pn; };
struct Gemm { const bf16_t* A; const bf16_t* Bt; const int* gidx; int M, N, K; };

struct StaticOrder {
    int nM, nN, nwg, G, c, wgm;
    __host__ __device__ void init(int M, int N, int G_, int c_, int wgm_ = WGM) { nM = M / BM; nN = N / BM; nwg = nM * nN; G = G_; c = c_; wgm = wgm_; }
    __host__ __device__ bool next(int i, Unit& u) const {
        const long L = (long)i * G + c; if (L >= nwg) return false;
        int wgid = (int)L; { const int q = nwg / NXCD, r = nwg % NXCD, xcd = wgid % NXCD, off = wgid / NXCD; wgid = (xcd < r ? xcd * (q + 1) : r * (q + 1) + (xcd - r) * q) + off; }
        const int nig = wgm * nN, gid = wgid / nig, fm = gid * wgm, gsz = (nM - fm) < wgm ? (nM - fm) : wgm;
        u.pm = fm + ((wgid % nig) % gsz); u.pn = (wgid % nig) / gsz; return true;
    }
    __device__ __forceinline__ void a_ready(const Unit&) const {}
    __device__ __forceinline__ void done(const Unit&) const {}
};
struct MoeOrder {
    StaticOrder so; const int* block_e;
    __device__ void init(int nblk_used, int G_, int c_, const int* be, int wgm_ = WGM) { so.init(nblk_used * BM, 4 * BM, G_, c_, wgm_); block_e = be; }
    __device__ bool next(int i, Unit& u) const { if (!so.next(i, u)) return false; u.pn = block_e[u.pm] * 4 + u.pn; return true; }
    __device__ __forceinline__ void a_ready(const Unit&) const {}
    __device__ __forceinline__ void done(const Unit&) const {}
};

__device__ __forceinline__ unsigned cvt_pk_bf16(float lo, float hi) { unsigned r; asm volatile("v_cvt_pk_bf16_f32 %0, %1, %2" : "=v"(r) : "v"(lo), "v"(hi)); return r; }
__device__ __forceinline__ float clamp_fp8(float v) { return __builtin_amdgcn_fmed3f(v, -448.0f, 448.0f); }
__device__ __forceinline__ unsigned cvt4_fp8(float a, float b, float c, float d) { int w = 0; w = __builtin_amdgcn_cvt_pk_fp8_f32(clamp_fp8(a), clamp_fp8(b), w, false); w = __builtin_amdgcn_cvt_pk_fp8_f32(clamp_fp8(c), clamp_fp8(d), w, true); return (unsigned)w; }
__device__ __forceinline__ float fast_silu(float x) { return x * __builtin_amdgcn_rcpf(1.0f + __builtin_amdgcn_exp2f(-1.4426950408889634f * x)); }

struct EpiBf16P {
    static constexpr bool PERM = true, ADJ = false, XS = false, AFTER_DRAIN = false, NEEDS_NOP = true;
    bf16_t* O; int ldc; int pad;
    __device__ __forceinline__ void operator()(const f32x4 (&acc)[2][2][4][2], const Unit& u, int wr, int wc, int fr, int fq) const {
        const int row0 = u.pm * BM + wr * 64 + fr, col0 = u.pn * BM + wc * 32 + 8 * fq;
        const bool act = pad && ((u.pn >> 1) == 2 || (u.pn >> 1) == 5);
#pragma unroll
        for (int ai = 0; ai < 2; ++ai)
#pragma unroll
            for (int m = 0; m < 4; ++m) { bf16_t* rowp = O + (size_t)(row0 + ai * HALF + m * 16) * ldc + col0;
#pragma unroll
                for (int bj = 0; bj < 2; ++bj) { f32x4 v0 = acc[ai][bj][m][0], v1 = acc[ai][bj][m][1];
                    if (act) {
#pragma unroll
                        for (int e = 0; e < 4; ++e) { v0[e] = fast_silu(v0[e]); v1[e] = fast_silu(v1[e]); } }
                    u32x4 w; w.x = cvt_pk_bf16(v0[0], v0[1]); w.y = cvt_pk_bf16(v0[2], v0[3]); w.z = cvt_pk_bf16(v1[0], v1[1]); w.w = cvt_pk_bf16(v1[2], v1[3]);
                    *(u32x4*)(rowp + bj * HALF) = w; } }
    }
};
struct EpiBf16PT {
    static constexpr bool PERM = true, ADJ = true, XS = true, AFTER_DRAIN = false, NEEDS_NOP = true;
    bf16_t* O; int ldc; int pad;
    __device__ __forceinline__ void operator()(const f32x4 (&acc)[2][2][4][2], const Unit& u, int wr, int wc, int fr, int fq, PG8_LAS unsigned char* xs) const {
        const int l_ = fq * 16 + fr, r_ = l_ >> 3, c_ = l_ & 7;
        const int woff = fr * 128 + ((fq ^ (fr & 7)) << 4), roff = r_ * 128 + ((c_ ^ r_) << 4);
        bf16_t* gp = O + (size_t)(u.pm * BM + wr * 64 + r_) * ldc + u.pn * BM + wc * 64 + 8 * c_;
        const bool act = pad && ((u.pn >> 1) == 2 || (u.pn >> 1) == 5);
        u32x4 pa, pb;
#pragma unroll
        for (int s_ = 0; s_ < 8; ++s_) { const int ai = s_ >> 2, m = s_ & 3;
#pragma unroll
            for (int bj = 0; bj < 2; ++bj) { f32x4 v0 = acc[ai][bj][m][0], v1 = acc[ai][bj][m][1];
                if (act) {
#pragma unroll
                    for (int e = 0; e < 4; ++e) { v0[e] = fast_silu(v0[e]); v1[e] = fast_silu(v1[e]); } }
                u32x4 w; w.x = cvt_pk_bf16(v0[0], v0[1]); w.y = cvt_pk_bf16(v0[2], v0[3]); w.z = cvt_pk_bf16(v1[0], v1[1]); w.w = cvt_pk_bf16(v1[2], v1[3]);
                *(PG8_LAS u32x4*)(xs + (woff ^ (bj << 6))) = w; }
            const u32x4 a = *(const PG8_LAS u32x4*)(xs + roff), b = *(const PG8_LAS u32x4*)(xs + roff + 1024);
            if (s_ > 0) { bf16_t* rp = gp + (size_t)(((s_ - 1) >> 2) * HALF + ((s_ - 1) & 3) * 16) * ldc; *(u32x4*)rp = pa; *(u32x4*)(rp + (size_t)8 * ldc) = pb; }
            pa = a; pb = b; }
        { bf16_t* rp = gp + (size_t)(HALF + 3 * 16) * ldc; *(u32x4*)rp = pa; *(u32x4*)(rp + (size_t)8 * ldc) = pb; }
    }
};
struct KvOrder {
    int G, c, tMem, tW;
    __device__ bool next(int i, Unit& u) const { const int L = i * G + c; if (L >= 256) return false;
        if (L < 128) { u.pm = tMem + (L >> 2); u.pn = tW + (L & 3); } else { const int l2 = L - 128; u.pm = tW + 4 + (l2 >> 5); u.pn = tMem + (l2 & 31); } return true; }
    __device__ __forceinline__ void a_ready(const Unit&) const {}
    __device__ __forceinline__ void done(const Unit&) const {}
};
struct EpiKV {
    static constexpr bool PERM = true, ADJ = false, XS = false, AFTER_DRAIN = false, NEEDS_NOP = false;
    bf16_t* KB; bf16_t* VT; int tMem, tW;
    __device__ __forceinline__ void operator()(const f32x4 (&acc)[2][2][4][2], const Unit& u, int wr, int wc, int fr, int fq) const {
        const bool isk = u.pm >= tMem; const int pm = isk ? u.pm - tMem : u.pm - (tW + 4), pn = isk ? u.pn - tW : u.pn - tMem;
        bf16_t* O = isk ? KB : VT; const int ldc = isk ? 1024 : 8192;
        const int row0 = pm * BM + wr * 64 + fr, col0 = pn * BM + wc * 32 + 8 * fq;
#pragma unroll
        for (int ai = 0; ai < 2; ++ai)
#pragma unroll
            for (int m = 0; m < 4; ++m) { bf16_t* rowp = O + (size_t)(row0 + ai * HALF + m * 16) * ldc + col0;
#pragma unroll
                for (int bj = 0; bj < 2; ++bj) { const f32x4 v0 = acc[ai][bj][m][0] * (1.0f / 64.0f), v1 = acc[ai][bj][m][1] * (1.0f / 64.0f);
                    u32x4 w; w.x = cvt_pk_bf16(v0[0], v0[1]); w.y = cvt_pk_bf16(v0[2], v0[3]); w.z = cvt_pk_bf16(v1[0], v1[1]); w.w = cvt_pk_bf16(v1[2], v1[3]);
                    *(u32x4*)(rowp + bj * HALF) = w; } }
    }
};
struct EpiResBf16Ssq {
    static constexpr bool PERM = true, ADJ = false, XS = false, AFTER_DRAIN = false, NEEDS_NOP = false;
    const float* invr; const float* invg; bf16_t* O; float* ssq; unsigned char* O8;
    __device__ __forceinline__ void operator()(const f32x4 (&acc)[2][2][4][2], const Unit& u, int wr, int wc, int fr, int fq) const {
        typedef unsigned u32x2 __attribute__((ext_vector_type(2)));
        const int row0 = u.pm * BM + wr * 64 + fr, col0 = u.pn * BM + wc * 32 + 8 * fq;
        f32x4 ig[2][2];
#pragma unroll
        for (int bj = 0; bj < 2; ++bj) { ig[bj][0] = *(const f32x4*)(invg + col0 + bj * HALF); ig[bj][1] = *(const f32x4*)(invg + col0 + bj * HALF + 4); }
#pragma unroll
        for (int ai = 0; ai < 2; ++ai) {
            u32x4 abv[4][2]; float irv[4];
#pragma unroll
            for (int m = 0; m < 4; ++m) { const int row = row0 + ai * HALF + m * 16; irv[m] = invr[row];
#pragma unroll
                for (int bj = 0; bj < 2; ++bj) abv[m][bj] = *(const u32x4*)(O + (size_t)row * 1024 + col0 + bj * HALF); }
            __builtin_amdgcn_sched_barrier(0);
#pragma unroll
            for (int m = 0; m < 4; ++m) { const int row = row0 + ai * HALF + m * 16; const size_t off = (size_t)row * 1024 + col0; const float ir = irv[m]; float s = 0.f;
#pragma unroll
                for (int bj = 0; bj < 2; ++bj) { const u32x4 ab = abv[m][bj];
                    const f32x4 x0 = {__uint_as_float(ab.x << 16), __uint_as_float(ab.x & 0xffff0000u), __uint_as_float(ab.y << 16), __uint_as_float(ab.y & 0xffff0000u)};
                    const f32x4 x1 = {__uint_as_float(ab.z << 16), __uint_as_float(ab.z & 0xffff0000u), __uint_as_float(ab.w << 16), __uint_as_float(ab.w & 0xffff0000u)};
                    const f32x4 v0 = acc[ai][bj][m][0] + x0 * ig[bj][0] * ir, v1 = acc[ai][bj][m][1] + x1 * ig[bj][1] * ir;
                    s += (v0[0] * v0[0] + v0[1] * v0[1]) + (v0[2] * v0[2] + v0[3] * v0[3]) + (v1[0] * v1[0] + v1[1] * v1[1]) + (v1[2] * v1[2] + v1[3] * v1[3]);
                    u32x4 w; w.x = cvt_pk_bf16(v0[0], v0[1]); w.y = cvt_pk_bf16(v0[2], v0[3]); w.z = cvt_pk_bf16(v1[0], v1[1]); w.w = cvt_pk_bf16(v1[2], v1[3]);
                    *(u32x4*)(O + off + bj * HALF) = w;
                    u32x2 w8; w8.x = cvt4_fp8(v0[0], v0[1], v0[2], v0[3]); w8.y = cvt4_fp8(v1[0], v1[1], v1[2], v1[3]); *(u32x2*)(O8 + off + bj * HALF) = w8; }
                s += __shfl_xor(s, 16); s += __shfl_xor(s, 32);
                if (fq == 0) ssq[(size_t)row * 16 + u.pn * 4 + wc] = s; }
        }
    }
};
struct EpiResBf16SsqT {
    static constexpr bool PERM = true, ADJ = true, XS = true, AFTER_DRAIN = false, NEEDS_NOP = false;
    const float* invr; const float* invg; bf16_t* O; float* ssq; unsigned char* O8;
    __device__ __forceinline__ void operator()(const f32x4 (&acc)[2][2][4][2], const Unit& u, int wr, int wc, int fr, int fq, PG8_LAS unsigned char* xs) const {
        typedef unsigned u32x2 __attribute__((ext_vector_type(2)));
        const int row0 = u.pm * BM + wr * 64 + fr, col0 = u.pn * BM + wc * 64 + 8 * fq;
        f32x4 ig[2][2];
#pragma unroll
        for (int bj = 0; bj < 2; ++bj) { ig[bj][0] = *(const f32x4*)(invg + col0 + bj * 32); ig[bj][1] = *(const f32x4*)(invg + col0 + bj * 32 + 4); }
        const int l_ = fq * 16 + fr, r_ = l_ >> 3, c_ = l_ & 7;
        const int woff = fr * 128 + ((fq ^ (fr & 7)) << 4), roff = r_ * 128 + ((c_ ^ r_) << 4);
        bf16_t* gp = O + (size_t)(u.pm * BM + wr * 64 + r_) * 1024 + u.pn * BM + wc * 64 + 8 * c_;
        u32x4 pa, pb; int pvoff = 0;
        const int r8_ = l_ >> 2, c8_ = l_ & 3;
        const int woff8 = 2048 + fr * 64 + (((fq >> 1) ^ ((fr >> 1) & 3)) << 4) + ((fq & 1) << 3), roff8 = 2048 + r8_ * 64 + ((c8_ ^ ((r8_ >> 1) & 3)) << 4);
        unsigned char* gp8 = O8 + (size_t)(u.pm * BM + wr * 64 + r8_) * 1024 + u.pn * BM + wc * 64 + 16 * c8_;
        u32x4 pv8;
#pragma unroll
        for (int ai = 0; ai < 2; ++ai) {
            u32x4 abv[4][2]; float irv[4];
#pragma unroll
            for (int m = 0; m < 4; ++m) { const int row = row0 + ai * HALF + m * 16; irv[m] = invr[row];
#pragma unroll
                for (int bj = 0; bj < 2; ++bj) abv[m][bj] = *(const u32x4*)(O + (size_t)row * 1024 + col0 + bj * 32); }
            __builtin_amdgcn_sched_barrier(0);
#pragma unroll
            for (int m = 0; m < 4; ++m) { const int row = row0 + ai * HALF + m * 16; const size_t off = (size_t)row * 1024 + col0; const float ir = irv[m]; float s = 0.f;
#pragma unroll
                for (int bj = 0; bj < 2; ++bj) { const u32x4 ab = abv[m][bj];
                    const f32x4 x0 = {__uint_as_float(ab.x << 16), __uint_as_float(ab.x & 0xffff0000u), __uint_as_float(ab.y << 16), __uint_as_float(ab.y & 0xffff0000u)};
                    const f32x4 x1 = {__uint_as_float(ab.z << 16), __uint_as_float(ab.z & 0xffff0000u), __uint_as_float(ab.w << 16), __uint_as_float(ab.w & 0xffff0000u)};
                    const f32x4 v0 = acc[ai][bj][m][0] + x0 * ig[bj][0] * ir, v1 = acc[ai][bj][m][1] + x1 * ig[bj][1] * ir;
                    s += (v0[0] * v0[0] + v0[1] * v0[1]) + (v0[2] * v0[2] + v0[3] * v0[3]) + (v1[0] * v1[0] + v1[1] * v1[1]) + (v1[2] * v1[2] + v1[3] * v1[3]);
                    u32x4 w; w.x = cvt_pk_bf16(v0[0], v0[1]); w.y = cvt_pk_bf16(v0[2], v0[3]); w.z = cvt_pk_bf16(v1[0], v1[1]); w.w = cvt_pk_bf16(v1[2], v1[3]);
                    *(PG8_LAS u32x4*)(xs + (woff ^ (bj << 6))) = w;
                    u32x2 w8; w8.x = cvt4_fp8(v0[0], v0[1], v0[2], v0[3]); w8.y = cvt4_fp8(v1[0], v1[1], v1[2], v1[3]); *(PG8_LAS u32x2*)(xs + (woff8 ^ (bj << 5))) = w8; }
                { const u32x4 a = *(const PG8_LAS u32x4*)(xs + roff), b = *(const PG8_LAS u32x4*)(xs + roff + 1024);
                  const u32x4 a8 = *(const PG8_LAS u32x4*)(xs + roff8);
                  if (ai + m > 0) { bf16_t* rp = gp + (size_t)pvoff * 1024; *(u32x4*)rp = pa; *(u32x4*)(rp + (size_t)8 * 1024) = pb; *(u32x4*)(gp8 + (size_t)pvoff * 1024) = pv8; }
                  pa = a; pb = b; pv8 = a8; pvoff = ai * HALF + m * 16; }
                s += __shfl_xor(s, 16); s += __shfl_xor(s, 32);
                if (fq == 0) ssq[(size_t)row * 16 + u.pn * 4 + wc] = s; }
        }
        { bf16_t* rp = gp + (size_t)pvoff * 1024; *(u32x4*)rp = pa; *(u32x4*)(rp + (size_t)8 * 1024) = pb; *(u32x4*)(gp8 + (size_t)pvoff * 1024) = pv8; }
    }
};
struct EpiBf16RowScale {
    static constexpr bool PERM = true, ADJ = false, XS = false, AFTER_DRAIN = false, NEEDS_NOP = false;
    bf16_t* O; const float* ssq; int ldc; float eps; float wscale; int pad;
    __device__ __forceinline__ void operator()(const f32x4 (&acc)[2][2][4][2], const Unit& u, int wr, int wc, int fr, int fq) const {
        const int row0 = u.pm * BM + wr * 64 + fr, col0 = u.pn * BM + wc * 32 + 8 * fq;
        float sv[2][4];
#pragma unroll
        for (int ai = 0; ai < 2; ++ai)
#pragma unroll
            for (int mp = 0; mp < 4; mp += 2) { f32x4 pv[2][4];
#pragma unroll
                for (int q = 0; q < 2; ++q) { const f32x4* sp = (const f32x4*)(ssq + (size_t)(row0 + ai * HALF + (mp + q) * 16) * 16);
#pragma unroll
                    for (int k = 0; k < 4; ++k) pv[q][k] = sp[k]; }
                __builtin_amdgcn_sched_barrier(0);
#pragma unroll
                for (int q = 0; q < 2; ++q) { const f32x4 p0 = pv[q][0], p1 = pv[q][1], p2 = pv[q][2], p3 = pv[q][3];
                    const float tot = (((p0[0] + p0[1]) + (p0[2] + p0[3])) + ((p1[0] + p1[1]) + (p1[2] + p1[3]))) + (((p2[0] + p2[1]) + (p2[2] + p2[3])) + ((p3[0] + p3[1]) + (p3[2] + p3[3])));
                    sv[ai][mp + q] = __builtin_amdgcn_rsqf(tot * (1.0f / 1024.0f) + eps) * wscale; } }
#pragma unroll
        for (int ai = 0; ai < 2; ++ai)
#pragma unroll
            for (int m = 0; m < 4; ++m) { const int row = row0 + ai * HALF + m * 16;
                const float s = sv[ai][m]; bf16_t* rowp = O + (size_t)row * ldc + col0;
#pragma unroll
                for (int bj = 0; bj < 2; ++bj) { const f32x4 v0 = acc[ai][bj][m][0] * s, v1 = acc[ai][bj][m][1] * s;
                    u32x4 w; w.x = cvt_pk_bf16(v0[0], v0[1]); w.y = cvt_pk_bf16(v0[2], v0[3]); w.z = cvt_pk_bf16(v1[0], v1[1]); w.w = cvt_pk_bf16(v1[2], v1[3]);
                    *(u32x4*)(rowp + bj * HALF) = w; } }
    }
};
struct EpiBf16RowScaleT {
    static constexpr bool PERM = true, ADJ = true, XS = true, AFTER_DRAIN = false, NEEDS_NOP = false;
    bf16_t* O; const float* ssq; int ldc; float eps; float wscale; int pad;
    __device__ __forceinline__ void operator()(const f32x4 (&acc)[2][2][4][2], const Unit& u, int wr, int wc, int fr, int fq, PG8_LAS unsigned char* xs) const {
        const int row0 = u.pm * BM + wr * 64 + fr;
        float sv[2][4];
#pragma unroll
        for (int ai = 0; ai < 2; ++ai)
#pragma unroll
            for (int mp = 0; mp < 4; mp += 2) { f32x4 pv[2][4];
#pragma unroll
                for (int q = 0; q < 2; ++q) { const f32x4* sp = (const f32x4*)(ssq + (size_t)(row0 + ai * HALF + (mp + q) * 16) * 16);
#pragma unroll
                    for (int k = 0; k < 4; ++k) pv[q][k] = sp[k]; }
                __builtin_amdgcn_sched_barrier(0);
#pragma unroll
                for (int q = 0; q < 2; ++q) { const f32x4 p0 = pv[q][0], p1 = pv[q][1], p2 = pv[q][2], p3 = pv[q][3];
                    const float tot = (((p0[0] + p0[1]) + (p0[2] + p0[3])) + ((p1[0] + p1[1]) + (p1[2] + p1[3]))) + (((p2[0] + p2[1]) + (p2[2] + p2[3])) + ((p3[0] + p3[1]) + (p3[2] + p3[3])));
                    sv[ai][mp + q] = __builtin_amdgcn_rsqf(tot * (1.0f / 1024.0f) + eps) * wscale; } }
        const int l_ = fq * 16 + fr, r_ = l_ >> 3, c_ = l_ & 7;
        const int woff = fr * 128 + ((fq ^ (fr & 7)) << 4), roff = r_ * 128 + ((c_ ^ r_) << 4);
        bf16_t* gp = O + (size_t)(u.pm * BM + wr * 64 + r_) * ldc + u.pn * BM + wc * 64 + 8 * c_;
        u32x4 pa, pb;
#pragma unroll
        for (int s_ = 0; s_ < 8; ++s_) { const int ai = s_ >> 2, m = s_ & 3; const float s = sv[ai][m];
#pragma unroll
            for (int bj = 0; bj < 2; ++bj) { const f32x4 v0 = acc[ai][bj][m][0] * s, v1 = acc[ai][bj][m][1] * s;
                u32x4 w; w.x = cvt_pk_bf16(v0[0], v0[1]); w.y = cvt_pk_bf16(v0[2], v0[3]); w.z = cvt_pk_bf16(v1[0], v1[1]); w.w = cvt_pk_bf16(v1[2], v1[3]);
                *(PG8_LAS u32x4*)(xs + (woff ^ (bj << 6))) = w; }
            const u32x4 a = *(const PG8_LAS u32x4*)(xs + roff), b = *(const PG8_LAS u32x4*)(xs + roff + 1024);
            if (s_ > 0) { bf16_t* rp = gp + (size_t)(((s_ - 1) >> 2) * HALF + ((s_ - 1) & 3) * 16) * ldc; *(u32x4*)rp = pa; *(u32x4*)(rp + (size_t)8 * ldc) = pb; }
            pa = a; pb = b; }
        { bf16_t* rp = gp + (size_t)(HALF + 3 * 16) * ldc; *(u32x4*)rp = pa; *(u32x4*)(rp + (size_t)8 * ldc) = pb; }
    }
};
struct EpiResBf16ToF32 {
    static constexpr bool PERM = false, ADJ = false, XS = false, AFTER_DRAIN = false, NEEDS_NOP = false;
    const bf16_t* Rb; float* C; float wscale; int pad;
    __device__ __forceinline__ void operator()(const f32x4 (&acc)[2][2][4][2], const Unit& u, int wr, int wc, int fr, int fq) const {
        typedef unsigned u32x2 __attribute__((ext_vector_type(2)));
        const int row0 = u.pm * BM + wr * 64 + fr, col0 = u.pn * BM + wc * 32 + 4 * fq;
#pragma unroll
        for (int ai = 0; ai < 2; ++ai)
#pragma unroll
            for (int m = 0; m < 4; ++m) { const size_t off = (size_t)(row0 + ai * HALF + m * 16) * 1024 + col0;
#pragma unroll
                for (int bj = 0; bj < 2; ++bj)
#pragma unroll
                    for (int n = 0; n < 2; ++n) { const u32x2 rb = *(const u32x2*)(Rb + off + bj * HALF + n * 16);
                        const f32x4 r = {__uint_as_float(rb.x << 16), __uint_as_float(rb.x & 0xffff0000u), __uint_as_float(rb.y << 16), __uint_as_float(rb.y & 0xffff0000u)};
                        *(f32x4*)(C + off + bj * HALF + n * 16) = r + acc[ai][bj][m][n] * wscale; } }
    }
};
struct EpiResBf16InPlace {
    static constexpr bool PERM = true, ADJ = false, XS = false, AFTER_DRAIN = false, NEEDS_NOP = false;
    const bf16_t* Rb; bf16_t* Ob; unsigned char* X8; const float* gain; float* ssq; float wscale; int pad;
    __device__ __forceinline__ void operator()(const f32x4 (&acc)[2][2][4][2], const Unit& u, int wr, int wc, int fr, int fq) const {
        typedef unsigned u32x2 __attribute__((ext_vector_type(2)));
        const int row0 = u.pm * BM + wr * 64 + fr, col0 = u.pn * BM + wc * 32 + 8 * fq;
        f32x4 gn[2][2];
#pragma unroll
        for (int bj = 0; bj < 2; ++bj) { gn[bj][0] = *(const f32x4*)(gain + col0 + bj * HALF); gn[bj][1] = *(const f32x4*)(gain + col0 + bj * HALF + 4); }
#pragma unroll
        for (int ai = 0; ai < 2; ++ai) {
            u32x4 rbv[4][2];
#pragma unroll
            for (int m = 0; m < 4; ++m)
#pragma unroll
                for (int bj = 0; bj < 2; ++bj) rbv[m][bj] = *(const u32x4*)(Rb + (size_t)(row0 + ai * HALF + m * 16) * 1024 + col0 + bj * HALF);
            __builtin_amdgcn_sched_barrier(0);
#pragma unroll
            for (int m = 0; m < 4; ++m) { const int row = row0 + ai * HALF + m * 16; const size_t off = (size_t)row * 1024 + col0; float s = 0.f;
#pragma unroll
                for (int bj = 0; bj < 2; ++bj) { const u32x4 rb = rbv[m][bj];
                    const f32x4 v0 = acc[ai][bj][m][0] * wscale + (f32x4){__uint_as_float(rb.x << 16), __uint_as_float(rb.x & 0xffff0000u), __uint_as_float(rb.y << 16), __uint_as_float(rb.y & 0xffff0000u)};
                    const f32x4 v1 = acc[ai][bj][m][1] * wscale + (f32x4){__uint_as_float(rb.z << 16), __uint_as_float(rb.z & 0xffff0000u), __uint_as_float(rb.w << 16), __uint_as_float(rb.w & 0xffff0000u)};
                    s += (v0[0] * v0[0] + v0[1] * v0[1]) + (v0[2] * v0[2] + v0[3] * v0[3]) + (v1[0] * v1[0] + v1[1] * v1[1]) + (v1[2] * v1[2] + v1[3] * v1[3]);
                    u32x4 w; w.x = cvt_pk_bf16(v0[0], v0[1]); w.y = cvt_pk_bf16(v0[2], v0[3]); w.z = cvt_pk_bf16(v1[0], v1[1]); w.w = cvt_pk_bf16(v1[2], v1[3]);
                    *(u32x4*)(Ob + off + bj * HALF) = w;
                    const f32x4 g0 = v0 * gn[bj][0], g1 = v1 * gn[bj][1];
                    u32x2 w8; w8.x = cvt4_fp8(g0[0], g0[1], g0[2], g0[3]); w8.y = cvt4_fp8(g1[0], g1[1], g1[2], g1[3]); *(u32x2*)(X8 + off + bj * HALF) = w8; }
                s += __shfl_xor(s, 16); s += __shfl_xor(s, 32);
                if (fq == 0) ssq[(size_t)row * 16 + u.pn * 4 + wc] = s; }
        }
    }
};
struct EpiResBf16InPlaceT {
    static constexpr bool PERM = true, ADJ = true, XS = true, AFTER_DRAIN = false, NEEDS_NOP = false;
    const bf16_t* Rb; bf16_t* Ob; unsigned char* X8; const float* gain; float* ssq; float wscale; int pad;
    __device__ __forceinline__ void operator()(const f32x4 (&acc)[2][2][4][2], const Unit& u, int wr, int wc, int fr, int fq, PG8_LAS unsigned char* xs) const {
        typedef unsigned u32x2 __attribute__((ext_vector_type(2)));
        const int row0 = u.pm * BM + wr * 64 + fr, col0 = u.pn * BM + wc * 64 + 8 * fq;
        f32x4 gn[2][2];
#pragma unroll
        for (int bj = 0; bj < 2; ++bj) { gn[bj][0] = *(const f32x4*)(gain + col0 + bj * 32); gn[bj][1] = *(const f32x4*)(gain + col0 + bj * 32 + 4); }
        const int l_ = fq * 16 + fr, r_ = l_ >> 3, c_ = l_ & 7;
        const int woff = fr * 128 + ((fq ^ (fr & 7)) << 4), roff = r_ * 128 + ((c_ ^ r_) << 4);
        bf16_t* gp = Ob + (size_t)(u.pm * BM + wr * 64 + r_) * 1024 + u.pn * BM + wc * 64 + 8 * c_;
        u32x4 pa, pb; int pvoff = 0;
        const int r8_ = l_ >> 2, c8_ = l_ & 3;
        const int woff8 = 2048 + fr * 64 + (((fq >> 1) ^ ((fr >> 1) & 3)) << 4) + ((fq & 1) << 3), roff8 = 2048 + r8_ * 64 + ((c8_ ^ ((r8_ >> 1) & 3)) << 4);
        unsigned char* gp8 = X8 + (size_t)(u.pm * BM + wr * 64 + r8_) * 1024 + u.pn * BM + wc * 64 + 16 * c8_;
        u32x4 pv8;
#pragma unroll
        for (int ai = 0; ai < 2; ++ai) {
            u32x4 rbv[4][2];
#pragma unroll
            for (int m = 0; m < 4; ++m)
#pragma unroll
                for (int bj = 0; bj < 2; ++bj) rbv[m][bj] = *(const u32x4*)(Rb + (size_t)(row0 + ai * HALF + m * 16) * 1024 + col0 + bj * 32);
            __builtin_amdgcn_sched_barrier(0);
#pragma unroll
            for (int m = 0; m < 4; ++m) { const int row = row0 + ai * HALF + m * 16; const size_t off = (size_t)row * 1024 + col0; float s = 0.f;
#pragma unroll
                for (int bj = 0; bj < 2; ++bj) { const u32x4 rb = rbv[m][bj];
                    const f32x4 v0 = acc[ai][bj][m][0] * wscale + (f32x4){__uint_as_float(rb.x << 16), __uint_as_float(rb.x & 0xffff0000u), __uint_as_float(rb.y << 16), __uint_as_float(rb.y & 0xffff0000u)};
                    const f32x4 v1 = acc[ai][bj][m][1] * wscale + (f32x4){__uint_as_float(rb.z << 16), __uint_as_float(rb.z & 0xffff0000u), __uint_as_float(rb.w << 16), __uint_as_float(rb.w & 0xffff0000u)};
                    s += (v0[0] * v0[0] + v0[1] * v0[1]) + (v0[2] * v0[2] + v0[3] * v0[3]) + (v1[0] * v1[0] + v1[1] * v1[1]) + (v1[2] * v1[2] + v1[3] * v1[3]);
                    u32x4 w; w.x = cvt_pk_bf16(v0[0], v0[1]); w.y = cvt_pk_bf16(v0[2], v0[3]); w.z = cvt_pk_bf16(v1[0], v1[1]); w.w = cvt_pk_bf16(v1[2], v1[3]);
                    *(PG8_LAS u32x4*)(xs + (woff ^ (bj << 6))) = w;
                    const f32x4 g0 = v0 * gn[bj][0], g1 = v1 * gn[bj][1];
                    u32x2 w8; w8.x = cvt4_fp8(g0[0], g0[1], g0[2], g0[3]); w8.y = cvt4_fp8(g1[0], g1[1], g1[2], g1[3]); *(PG8_LAS u32x2*)(xs + (woff8 ^ (bj << 5))) = w8; }
                { const u32x4 a = *(const PG8_LAS u32x4*)(xs + roff), b = *(const PG8_LAS u32x4*)(xs + roff + 1024);
                  const u32x4 a8 = *(const PG8_LAS u32x4*)(xs + roff8);
                  if (ai + m > 0) { bf16_t* rp = gp + (size_t)pvoff * 1024; *(u32x4*)rp = pa; *(u32x4*)(rp + (size_t)8 * 1024) = pb; *(u32x4*)(gp8 + (size_t)pvoff * 1024) = pv8; }
                  pa = a; pb = b; pv8 = a8; pvoff = ai * HALF + m * 16; }
                s += __shfl_xor(s, 16); s += __shfl_xor(s, 32);
                if (fq == 0) ssq[(size_t)row * 16 + u.pn * 4 + wc] = s; }
        }
        { bf16_t* rp = gp + (size_t)pvoff * 1024; *(u32x4*)rp = pa; *(u32x4*)(rp + (size_t)8 * 1024) = pb; *(u32x4*)(gp8 + (size_t)pvoff * 1024) = pv8; }
    }
};
struct EpiMoe1 {
    static constexpr bool PERM = true, ADJ = false, XS = false, AFTER_DRAIN = false, NEEDS_NOP = false;
    bf16_t* H; const float* rsl;
    __device__ __forceinline__ void operator()(const f32x4 (&acc)[2][2][4][2], const Unit& u, int wr, int wc, int fr, int fq) const {
        const int row0 = u.pm * BM + wr * 64 + fr, col0 = (u.pn & 3) * 128 + wc * 32 + 8 * fq;
#pragma unroll
        for (int ai = 0; ai < 2; ++ai)
#pragma unroll
            for (int m = 0; m < 4; ++m) { const int row = row0 + ai * HALF + m * 16; const float sc = rsl[row]; bf16_t* rowp = H + (size_t)row * 512 + col0;
                const f32x4 g0 = acc[ai][0][m][0] * sc, g1 = acc[ai][0][m][1] * sc, u0 = acc[ai][1][m][0] * sc, u1 = acc[ai][1][m][1] * sc;
                u32x4 w; w.x = cvt_pk_bf16(fast_silu(g0[0]) * u0[0], fast_silu(g0[1]) * u0[1]); w.y = cvt_pk_bf16(fast_silu(g0[2]) * u0[2], fast_silu(g0[3]) * u0[3]);
                w.z = cvt_pk_bf16(fast_silu(g1[0]) * u1[0], fast_silu(g1[1]) * u1[1]); w.w = cvt_pk_bf16(fast_silu(g1[2]) * u1[2], fast_silu(g1[3]) * u1[3]);
                *(u32x4*)rowp = w; }
    }
};
struct EpiMoe1F8 {
    static constexpr bool PERM = true, ADJ = false, XS = false, AFTER_DRAIN = false, NEEDS_NOP = false;
    unsigned char* H; const float* rsl;
    __device__ __forceinline__ void operator()(const f32x4 (&acc)[2][2][4][2], const Unit& u, int wr, int wc, int fr, int fq) const {
        typedef unsigned u32x2 __attribute__((ext_vector_type(2)));
        const int row0 = u.pm * BM + wr * 64 + fr, col0 = (u.pn & 3) * 128 + wc * 32 + 8 * fq;
        float scv[2][4];
#pragma unroll
        for (int ai = 0; ai < 2; ++ai)
#pragma unroll
            for (int m = 0; m < 4; ++m) scv[ai][m] = rsl[row0 + ai * HALF + m * 16];
        __builtin_amdgcn_sched_barrier(0);
#pragma unroll
        for (int ai = 0; ai < 2; ++ai)
#pragma unroll
            for (int m = 0; m < 4; ++m) { const int row = row0 + ai * HALF + m * 16; const float sc = scv[ai][m] * (1.0f / 64.0f);
                const f32x4 g0 = acc[ai][0][m][0] * sc, g1 = acc[ai][0][m][1] * sc, u0 = acc[ai][1][m][0] * sc, u1 = acc[ai][1][m][1] * sc;
                u32x2 w; w.x = cvt4_fp8(fast_silu(g0[0]) * u0[0], fast_silu(g0[1]) * u0[1], fast_silu(g0[2]) * u0[2], fast_silu(g0[3]) * u0[3]);
                w.y = cvt4_fp8(fast_silu(g1[0]) * u1[0], fast_silu(g1[1]) * u1[1], fast_silu(g1[2]) * u1[2], fast_silu(g1[3]) * u1[3]);
                *(u32x2*)(H + (size_t)row * 512 + col0) = w; }
    }
};
struct EpiMoe2 {
    static constexpr bool PERM = true, ADJ = false, XS = false, AFTER_DRAIN = false, NEEDS_NOP = false;
    unsigned char* Yb; const float* gate; float wscale; int pad;
    __device__ __forceinline__ void operator()(const f32x4 (&acc)[2][2][4][2], const Unit& u, int wr, int wc, int fr, int fq) const {
        typedef unsigned u32x2 __attribute__((ext_vector_type(2)));
        const int row0 = u.pm * BM + wr * 64 + fr, col0 = (u.pn & 3) * BM + wc * 32 + 8 * fq;
        float gtv[2][4];
#pragma unroll
        for (int ai = 0; ai < 2; ++ai)
#pragma unroll
            for (int m = 0; m < 4; ++m) gtv[ai][m] = gate[row0 + ai * HALF + m * 16];
        __builtin_amdgcn_sched_barrier(0);
#pragma unroll
        for (int ai = 0; ai < 2; ++ai)
#pragma unroll
            for (int m = 0; m < 4; ++m) { const int row = row0 + ai * HALF + m * 16; const float s = gtv[ai][m] * wscale * 16.0f; unsigned char* rowp = Yb + (size_t)row * 1024 + col0;
#pragma unroll
                for (int bj = 0; bj < 2; ++bj) { const f32x4 v0 = acc[ai][bj][m][0] * s, v1 = acc[ai][bj][m][1] * s;
                    u32x2 w; w.x = cvt4_fp8(v0[0], v0[1], v0[2], v0[3]); w.y = cvt4_fp8(v1[0], v1[1], v1[2], v1[3]);
                    *(u32x2*)(rowp + bj * HALF) = w; } }
    }
};

struct EpiMoe1F8T {
    static constexpr bool PERM = true, ADJ = false, XS = true, AFTER_DRAIN = false, NEEDS_NOP = false;
    unsigned char* H; const float* rsl;
    __device__ __forceinline__ void operator()(const f32x4 (&acc)[2][2][4][2], const Unit& u, int wr, int wc, int fr, int fq, PG8_LAS unsigned char* xs) const {
        typedef unsigned u32x2 __attribute__((ext_vector_type(2)));
        const int row0 = u.pm * BM + wr * 64 + fr;
        float scv[2][4];
#pragma unroll
        for (int ai = 0; ai < 2; ++ai)
#pragma unroll
            for (int m = 0; m < 4; ++m) scv[ai][m] = rsl[row0 + ai * HALF + m * 16];
        __builtin_amdgcn_sched_barrier(0);
        const int l_ = fq * 16 + fr, R_ = l_ >> 1, c_ = l_ & 1;
        const int woff = fr * 32 + (((fq >> 1) ^ ((fr >> 2) & 1)) << 4) + ((fq & 1) << 3);
        const int roff = R_ * 32 + ((c_ ^ ((R_ >> 2) & 1)) << 4);
        unsigned char* gp = H + (size_t)(u.pm * BM + wr * 64 + (R_ >> 4) * 16 + (R_ & 15)) * 512 + (u.pn & 3) * 128 + wc * 32 + 16 * c_;
        u32x4 pv;
#pragma unroll
        for (int t_ = 0; t_ < 4; ++t_) { const int ai = t_ >> 1, mp = t_ & 1;
            PG8_LAS unsigned char* xb = xs + (t_ & 1) * 1024;
#pragma unroll
            for (int q = 0; q < 2; ++q) { const int m = 2 * mp + q; const float sc = scv[ai][m] * (1.0f / 64.0f);
                const f32x4 g0 = acc[ai][0][m][0] * sc, g1 = acc[ai][0][m][1] * sc, u0 = acc[ai][1][m][0] * sc, u1 = acc[ai][1][m][1] * sc;
                u32x2 w; w.x = cvt4_fp8(fast_silu(g0[0]) * u0[0], fast_silu(g0[1]) * u0[1], fast_silu(g0[2]) * u0[2], fast_silu(g0[3]) * u0[3]);
                w.y = cvt4_fp8(fast_silu(g1[0]) * u1[0], fast_silu(g1[1]) * u1[1], fast_silu(g1[2]) * u1[2], fast_silu(g1[3]) * u1[3]);
                *(PG8_LAS u32x2*)(xb + q * 512 + woff) = w; }
            const u32x4 a = *(const PG8_LAS u32x4*)(xb + roff);
            if (t_ > 0) *(u32x4*)(gp + (size_t)(((t_ - 1) >> 1) * HALF + ((t_ - 1) & 1) * 32) * 512) = pv;
            pv = a; }
        *(u32x4*)(gp + (size_t)(HALF + 32) * 512) = pv;
    }
};
struct EpiMoe2T {
    static constexpr bool PERM = true, ADJ = true, XS = true, AFTER_DRAIN = false, NEEDS_NOP = false;
    unsigned char* Yb; const float* gate; float wscale; int pad;
    __device__ __forceinline__ void operator()(const f32x4 (&acc)[2][2][4][2], const Unit& u, int wr, int wc, int fr, int fq, PG8_LAS unsigned char* xs) const {
        typedef unsigned u32x2 __attribute__((ext_vector_type(2)));
        const int row0 = u.pm * BM + wr * 64 + fr;
        float gtv[2][4];
#pragma unroll
        for (int ai = 0; ai < 2; ++ai)
#pragma unroll
            for (int m = 0; m < 4; ++m) gtv[ai][m] = gate[row0 + ai * HALF + m * 16];
        __builtin_amdgcn_sched_barrier(0);
        const int l_ = fq * 16 + fr, r_ = l_ >> 2, c_ = l_ & 3;
        const int woff = fr * 64 + (((fq >> 1) ^ ((fr >> 1) & 3)) << 4) + ((fq & 1) << 3);
        const int roff = r_ * 64 + ((c_ ^ ((r_ >> 1) & 3)) << 4);
        unsigned char* gp = Yb + (size_t)(u.pm * BM + wr * 64 + r_) * 1024 + (u.pn & 3) * BM + wc * 64 + 16 * c_;
        u32x4 pv;
#pragma unroll
        for (int s_ = 0; s_ < 8; ++s_) { const int ai = s_ >> 2, m = s_ & 3; const float s = gtv[ai][m] * wscale * 16.0f;
            PG8_LAS unsigned char* xb = xs + (s_ & 1) * 1024;
#pragma unroll
            for (int bj = 0; bj < 2; ++bj) { const f32x4 v0 = acc[ai][bj][m][0] * s, v1 = acc[ai][bj][m][1] * s;
                u32x2 w; w.x = cvt4_fp8(v0[0], v0[1], v0[2], v0[3]); w.y = cvt4_fp8(v1[0], v1[1], v1[2], v1[3]);
                *(PG8_LAS u32x2*)(xb + (woff ^ (bj << 5))) = w; }
            const u32x4 a = *(const PG8_LAS u32x4*)(xb + roff);
            if (s_ > 0) *(u32x4*)(gp + (size_t)(((s_ - 1) >> 2) * HALF + ((s_ - 1) & 3) * 16) * 1024) = pv;
            pv = a; }
        *(u32x4*)(gp + (size_t)(HALF + 3 * 16) * 1024) = pv;
    }
};

template <class Epi, class Sched, bool ALIGN_EPI, bool GATHER, bool FP8 = false>
__device__ __forceinline__ void gemm_phase(PG8_LAS unsigned char* lds, const Gemm g, const Sched& S, const Epi& E) {
    const int tid = threadIdx.x, wid = __builtin_amdgcn_readfirstlane(tid >> 6), lane = tid & 63, wr = wid >> 2, wc = wid & 3, fr = lane & 15, fq = lane >> 4;
    const int K = g.K, Kb = FP8 ? K : 2 * K  , nt = Kb / 128;
    unsigned voffA[2], voffB[2];
#pragma unroll
    for (int i = 0; i < 2; ++i) { int R, C; stage_rc(tid * 16 + i * 8192, R, C); const int Rb = Epi::PERM ? ((R & ~31) + perm32(R & 31)) : R;
        const int Rb2 = Epi::ADJ ? ((R >> 5) * 64 + perm32(R & 31)) : Rb;
        voffA[i] = (unsigned)(R * Kb + 2 * C); voffB[i] = (unsigned)(Rb2 * Kb + 2 * C); }
    const size_t kstep = 128;
    const size_t hstep = (size_t)HALF * Kb;
    const size_t tstep = 2 * hstep;
    const size_t hsA = GATHER ? 0 : hstep;
    const size_t hsB = Epi::ADJ ? (size_t)32 * Kb : hstep;
    const unsigned ldsw = (unsigned)wid * 1024u;
    const int aoff = lds_byte(wr * 64 + fr, FP8 ? fq * 16 : fq * 8), boff = lds_byte(wc * 32 + fr, FP8 ? fq * 16 : fq * 8);
#define PG8_SA(b, h) (((b) * 2 + (h)) * HTB)
#define PG8_SB(b, h) ((4 + (b) * 2 + (h)) * HTB)
#define PG8_STAGE(bufoff, gbase, voff) do { _Pragma("unroll") for (int _i = 0; _i < 2; ++_i) \
        __builtin_amdgcn_global_load_lds((const unsigned*)((const char*)(gbase) + (voff)[_i]), (PG8_LAS unsigned*)(lds + (bufoff) + ldsw + _i * 8192), 16, 0, 0); } while (0)
#define PG8_LDF(dst, off_) do { if constexpr (FP8) { const i32x4_ lo_ = *(const PG8_LAS i32x4_*)(lds + (off_)), hi_ = *(const PG8_LAS i32x4_*)(lds + (off_) + 16); dst = __builtin_shufflevector(lo_, hi_, 0, 1, 2, 3, 4, 5, 6, 7); } \
        else { dst[0] = *(const PG8_LAS bf16x8*)(lds + (off_)); dst[1] = *(const PG8_LAS bf16x8*)(lds + (off_) + 1024); } } while (0)
#define PG8_LDA(dst, b, h) do { _Pragma("unroll") for (int m = 0; m < 4; ++m) PG8_LDF(dst[m], PG8_SA(b, h) + aoff + m * 2048); } while (0)
#define PG8_LDB(dst, b, h) do { _Pragma("unroll") for (int n = 0; n < 2; ++n) PG8_LDF(dst[n], PG8_SB(b, h) + boff + n * 2048); } while (0)
#define PG8_MMA(ai, bj, At, Bt) do { __builtin_amdgcn_s_setprio(1); _Pragma("unroll") for (int m = 0; m < 4; ++m) _Pragma("unroll") for (int n = 0; n < 2; ++n) { \
        if constexpr (FP8) asm volatile("v_mfma_scale_f32_16x16x128_f8f6f4 %0, %1, %2, %0, %3, %3 op_sel_hi:[0,0,0]" : "+v"(acc[ai][bj][m][n]) : "v"(Bt[n]), "v"(At[m]), "v"(sc1_));     \
        else { _Pragma("unroll") for (int k = 0; k < 2; ++k) acc[ai][bj][m][n] = __builtin_amdgcn_mfma_f32_16x16x32_bf16(Bt[n][k], At[m][k], acc[ai][bj][m][n], 0, 0, 0); } } __builtin_amdgcn_s_setprio(0); } while (0)
#define PG8_WAIT_V(n) asm volatile("s_waitcnt vmcnt(" #n ")" ::: "memory")
#define PG8_WAIT_L(n) asm volatile("s_waitcnt lgkmcnt(" #n ")" ::: "memory")
#define PG8_BAR __builtin_amdgcn_s_barrier()
#define PG8_SCHED __builtin_amdgcn_sched_barrier(0)
    unsigned vc0[2], vc1[2], vn0[2], vn1[2];
#define PG8_LOADIDX(v0, v1, pm_) do { _Pragma("unroll") for (int _i = 0; _i < 2; ++_i) { int R_, C_; stage_rc(tid * 16 + _i * 8192, R_, C_); \
        v0[_i] = (unsigned)g.gidx[(pm_) * BM + R_] * (unsigned)Kb + 2u * (unsigned)C_; v1[_i] = (unsigned)g.gidx[(pm_) * BM + HALF + R_] * (unsigned)Kb + 2u * (unsigned)C_; } } while (0)
    Unit cur, nxt; int ui = 0;
    if (!S.next(0, cur)) return;
    f32x4 acc[2][2][4][2];
#pragma unroll
    for (int a = 0; a < 2; ++a)
#pragma unroll
        for (int b = 0; b < 2; ++b)
#pragma unroll
            for (int m = 0; m < 4; ++m)
#pragma unroll
                for (int n = 0; n < 2; ++n) acc[a][b][m][n] = (f32x4){0.f, 0.f, 0.f, 0.f};
    typedef int i32x4_ __attribute__((ext_vector_type(4))); typedef int i32x8_ __attribute__((ext_vector_type(8)));
    struct FragB { bf16x8 k[2]; __device__ __forceinline__ bf16x8& operator[](int i) { return k[i]; } };
    typedef typename std::conditional<FP8, i32x8_, FragB>::type frag_t;
    frag_t At[4], B0[2], B1[2];
    const int sc1_ = 0x7f7f7f7f;
    if constexpr (GATHER) { PG8_LOADIDX(vc0, vc1, cur.pm); } else {
#pragma unroll
        for (int i = 0; i < 2; ++i) { vc0[i] = voffA[i]; vc1[i] = voffA[i]; } }
    const char* cA = GATHER ? (const char*)g.A : (const char*)g.A + (size_t)cur.pm * tstep; const char* cB = (const char*)g.Bt + (size_t)cur.pn * tstep;
    S.a_ready(cur);
    PG8_STAGE(PG8_SB(0, 0), cB, voffB); PG8_STAGE(PG8_SB(0, 1), cB + hsB, voffB); PG8_STAGE(PG8_SA(0, 0), cA, vc0); PG8_STAGE(PG8_SA(0, 1), cA + hsA, vc1);
    if (wr == 1) PG8_BAR;
    PG8_WAIT_V(2); PG8_BAR;
    PG8_STAGE(PG8_SB(1, 0), cB + kstep, voffB); PG8_STAGE(PG8_SA(1, 0), cA + kstep, vc0); PG8_STAGE(PG8_SB(1, 1), cB + hsB + kstep, voffB);
    PG8_WAIT_V(6); PG8_BAR;
    for (;;) {
        const bool has_next = S.next(ui + 1, nxt);
        const char* nA = GATHER ? cA : (has_next ? (const char*)g.A + (size_t)nxt.pm * tstep : cA); const char* nB = has_next ? (const char*)g.Bt + (size_t)nxt.pn * tstep : cB;
        if constexpr (GATHER) { if (has_next) { PG8_LOADIDX(vn0, vn1, nxt.pm); } else {
#pragma unroll
            for (int i = 0; i < 2; ++i) { vn0[i] = vc0[i]; vn1[i] = vc1[i]; } } }
#pragma unroll 1
        for (int t = 0; t < nt; t += 2) {
            const bool last = (t == nt - 2);
            const char* a1 = cA + (size_t)(t + 1) * kstep;
            const char* a2 = last ? nA : cA + (size_t)(t + 2) * kstep; const char* b2 = last ? nB : cB + (size_t)(t + 2) * kstep;
            const char* a3 = a2 + kstep; const char* b3 = b2 + kstep;
            unsigned w0[2], w1[2];
#pragma unroll
            for (int i = 0; i < 2; ++i) { w0[i] = (GATHER && last) ? vn0[i] : vc0[i]; w1[i] = (GATHER && last) ? vn1[i] : vc1[i]; }
            if (last && has_next) S.a_ready(nxt);
            PG8_LDB(B0, 0, 0); PG8_LDB(B1, 0, 1); PG8_SCHED; PG8_LDA(At, 0, 0); PG8_STAGE(PG8_SA(1, 1), a1 + hsA, vc1);
            PG8_WAIT_V(8); PG8_WAIT_L(0); PG8_BAR; PG8_MMA(0, 0, At, B0); PG8_MMA(0, 1, At, B1); PG8_BAR; PG8_SCHED;
            PG8_LDA(At, 0, 1); PG8_STAGE(PG8_SB(0, 0), b2, voffB); PG8_STAGE(PG8_SB(0, 1), b2 + hsB, voffB); PG8_STAGE(PG8_SA(0, 0), a2, w0);
            PG8_WAIT_V(8); PG8_WAIT_L(0); PG8_BAR; PG8_MMA(1, 0, At, B0); PG8_MMA(1, 1, At, B1); PG8_BAR; PG8_SCHED;
            PG8_LDB(B0, 1, 0); PG8_LDB(B1, 1, 1); PG8_SCHED; PG8_LDA(At, 1, 0); PG8_STAGE(PG8_SA(0, 1), a2 + hsA, w1);
            PG8_WAIT_V(8); PG8_WAIT_L(0); PG8_BAR; PG8_MMA(0, 0, At, B0); PG8_MMA(0, 1, At, B1); PG8_BAR; PG8_SCHED;
            PG8_LDA(At, 1, 1); PG8_STAGE(PG8_SB(1, 0), b3, voffB); PG8_STAGE(PG8_SB(1, 1), b3 + hsB, voffB); PG8_STAGE(PG8_SA(1, 0), a3, w0);
            PG8_WAIT_V(8); PG8_WAIT_L(0); PG8_BAR; PG8_MMA(1, 0, At, B0); PG8_MMA(1, 1, At, B1); PG8_BAR; PG8_SCHED;
        }
        if constexpr (ALIGN_EPI) { if (wr == 0) PG8_BAR; }
        if constexpr (FP8 || Epi::NEEDS_NOP) asm volatile("s_nop 15\n\ts_nop 15" ::: "memory");
        if constexpr (Epi::XS) E(acc, cur, wr, wc, fr, fq, lds + STAGE_BYTES + wid * 3072); else E(acc, cur, wr, wc, fr, fq);
        S.done(cur);
        if (!has_next) break;
#pragma unroll
        for (int a = 0; a < 2; ++a)
#pragma unroll
            for (int b = 0; b < 2; ++b)
#pragma unroll
                for (int m = 0; m < 4; ++m)
#pragma unroll
                    for (int n = 0; n < 2; ++n) acc[a][b][m][n] = (f32x4){0.f, 0.f, 0.f, 0.f};
        cur = nxt; cA = nA; cB = nB; ++ui;
        if constexpr (GATHER) {
#pragma unroll
            for (int i = 0; i < 2; ++i) { vc0[i] = vn0[i]; vc1[i] = vn1[i]; } }
        if constexpr (ALIGN_EPI) { if (wr == 1) PG8_BAR; }
    }
    PG8_WAIT_V(0);
    if constexpr (!ALIGN_EPI) { if (wr == 0) PG8_BAR; }
    PG8_BAR;
#undef PG8_SA
#undef PG8_SB
#undef PG8_STAGE
#undef PG8_LDA
#undef PG8_LDF
#undef PG8_LDB
#undef PG8_MMA
#undef PG8_WAIT_V
#undef PG8_WAIT_L
#undef PG8_BAR
#undef PG8_SCHED
#undef PG8_LOADIDX
}
}
#define GAS __attribute__((address_space(1)))
#define LAS __attribute__((address_space(3)))
typedef unsigned v4u __attribute__((ext_vector_type(4)));
typedef float f32x4 __attribute__((ext_vector_type(4)));
typedef float f32x2v __attribute__((ext_vector_type(2)));
#define LDS_WAIT() asm volatile("s_waitcnt lgkmcnt(0)" ::: "memory")
#define VM_WAIT() asm volatile("s_waitcnt vmcnt(0)" ::: "memory")
constexpr int NWAVES = 8;
#ifndef TAIL_GATE
#define TAIL_GATE 1
#endif
#ifndef TAIL_HFRAC
#define TAIL_HFRAC 4
#endif
#ifndef P1EPI
#define P1EPI EpiBf16PT
#endif
#ifndef P5EPI
#define P5EPI EpiBf16RowScaleT
#endif
#ifndef P7EPI
#define P7EPI EpiResBf16InPlaceT
#endif
#ifndef P3EPI
#define P3EPI EpiResBf16SsqT
#endif
#ifndef WGM_P1
#define WGM_P1 4
#endif
#ifndef WGM_N1K
#define WGM_N1K 8
#endif
#ifndef WGM_MOE
#define WGM_MOE 4
#endif
constexpr int RING_OFF = 0, RING_BYTES = 131072;
constexpr int LDSCTL_OFF = 163840 - 1024, MISC_OFF = LDSCTL_OFF + 320;
constexpr int LDS_BYTES = 163840;
constexpr int CW_BAR = 4096;
constexpr size_t CTL_ZERO_BYTES = 64 * 1024;

__device__ __forceinline__ unsigned pk2(float lo, float hi) { return (unsigned)f2bf(lo) | ((unsigned)f2bf(hi) << 16); }

#define XB_TMO      128
#define XB_XCNT(j)  (256  + 64 * (j))
#define XB_XSUB(j)  (1280 + 64 * (j))
#define XB_XGEN(j)  (2304 + 64 * (j))
#define XB_TOP      3328
#define XB_TOPGEN   3392
#define XCD_BAR_WORDS 3456
#define XB_SPIN_CAP (1u << 18)

__device__ __forceinline__ unsigned xb_ld(unsigned* p)              { return __hip_atomic_load(p, __ATOMIC_RELAXED, __HIP_MEMORY_SCOPE_AGENT); }
__device__ __forceinline__ unsigned xb_add(unsigned* p, unsigned v) { return __hip_atomic_fetch_add(p, v, __ATOMIC_RELAXED, __HIP_MEMORY_SCOPE_AGENT); }
__device__ __forceinline__ unsigned xb_xcc_id() { return (unsigned)__builtin_amdgcn_s_getreg((3 << 11) | 20) & 0xFu; }
#define XB_SPIN(cond, bar) do { unsigned _sp = 0; while (cond) { __builtin_amdgcn_s_sleep(1); \
    if ((++_sp & 255u) == 0u) { if (xb_ld(&(bar)[XB_TMO])) break; if (_sp > XB_SPIN_CAP) { atomicAdd(&(bar)[XB_TMO], 1u); break; } } } } while (0)

struct XcdBarrier {
    unsigned* bar; unsigned x;
    volatile LAS unsigned* st;
};
__device__ __forceinline__ XcdBarrier xcd_barrier_post(unsigned* bar, volatile LAS unsigned* st) {
    XcdBarrier b; b.bar = bar; b.x = xb_xcc_id(); b.st = st;
    if (threadIdx.x == 0) (void)xb_add(&bar[XB_XCNT(b.x)], 1u);
    return b;
}
__device__ __forceinline__ void xcd_barrier_complete(unsigned* bar, unsigned x, unsigned& nloc, unsigned& nx) {
    const unsigned G = gridDim.x * gridDim.y * gridDim.z;
    unsigned sum, cnt, mine, sp = 0u;
    for (;;) {
        sum = 0u; cnt = 0u; mine = 0u;
#pragma unroll
        for (unsigned j = 0; j < 16; ++j) { const unsigned c = xb_ld(&bar[XB_XCNT(j)]); sum += c; cnt += (c > 0u) ? 1u : 0u; mine = (j == x) ? c : mine; }
        if (sum == G) break;
        __builtin_amdgcn_s_sleep(1);
        if ((++sp & 255u) == 0u) { if (xb_ld(&bar[XB_TMO])) break; if (sp > XB_SPIN_CAP) { atomicAdd(&bar[XB_TMO], 1u); break; } }
    }
    nloc = mine > 0u ? mine : 1u; nx = cnt > 0u ? cnt : 1u;
}
__device__ __forceinline__ void xcd_barrier(const XcdBarrier& b) {
    asm volatile("s_waitcnt vmcnt(0)" ::: "memory");
    __syncthreads();
    if (threadIdx.x == 0) {
        unsigned* bar = b.bar;
        __builtin_amdgcn_s_waitcnt(0);
        unsigned nloc = b.st[0], nx = b.st[1];
        if (nloc == 0u) { xcd_barrier_complete(bar, b.x, nloc, nx); b.st[0] = nloc; b.st[1] = nx; }
        const unsigned old = xb_add(&bar[XB_XSUB(b.x)], 1u);
        const unsigned gen = old / nloc;
        if (old + 1u == (gen + 1u) * nloc) {
            __builtin_amdgcn_fence(__ATOMIC_RELEASE, "agent");
            asm volatile("s_waitcnt vmcnt(0)" ::: "memory");
            const unsigned og = xb_add(&bar[XB_TOP], 1u);
            const unsigned tg = og / nx;
            if (og + 1u == (tg + 1u) * nx) xb_add(&bar[XB_TOPGEN], 1u);
            else XB_SPIN(xb_ld(&bar[XB_TOPGEN]) == tg, bar);
            __builtin_amdgcn_fence(__ATOMIC_ACQUIRE, "agent");
            xb_add(&bar[XB_XGEN(b.x)], 1u);
            asm volatile("s_waitcnt vmcnt(0)" ::: "memory");
        } else {
            XB_SPIN(xb_ld(&bar[XB_XGEN(b.x)]) == gen, bar);
            __builtin_amdgcn_fence(__ATOMIC_ACQUIRE, "agent");
            asm volatile("s_waitcnt vmcnt(0)" ::: "memory");
        }
    }
    __syncthreads();
}

__device__ __forceinline__ void p0_transpose_item(const float* W, int K, int N, bf16* WT, int row_off, LAS float* scr, int kb, int nb, int lane, const float* gk = nullptr) {
    const int k0 = 64 * kb, n0 = 32 * nb;
#pragma unroll
    for (int i = 0; i < 32; ++i) { const int kk = 2 * i + (lane >> 5); scr[kk * 33 + (lane & 31)] = W[(size_t)(k0 + kk) * N + n0 + (lane & 31)] * (gk ? gk[k0 + kk] : 1.0f); }
    LDS_WAIT(); asm volatile("" ::: "memory");
    const int c = lane & 7;
#pragma unroll
    for (int j = 0; j < 4; ++j) { const int n = (lane >> 3) + 8 * j; const LAS float* s = scr + (8 * c) * 33 + n;
        v4u o; o.x = pk2(s[0 * 33], s[1 * 33]); o.y = pk2(s[2 * 33], s[3 * 33]); o.z = pk2(s[4 * 33], s[5 * 33]); o.w = pk2(s[6 * 33], s[7 * 33]);
        *(GAS v4u*)(WT + (size_t)(row_off + n0 + n) * K + k0 + 8 * c) = o; }
    LDS_WAIT(); asm volatile("" ::: "memory");
}
__device__ __forceinline__ void p0_transpose_item8(const float* W, int K, int N, unsigned char* WT, int row_off, LAS float* scr, int kb, int nb, int lane, float scale, const float* gk = nullptr) {
    typedef unsigned v2u_ __attribute__((ext_vector_type(2)));
    const int k0 = 64 * kb, n0 = 32 * nb;
    float wv[32];
#pragma unroll
    for (int i = 0; i < 32; ++i) { const int kk = 2 * i + (lane >> 5); wv[i] = W[(size_t)(k0 + kk) * N + n0 + (lane & 31)]; }
    if (gk) {
#pragma unroll
        for (int i = 0; i < 32; ++i) wv[i] *= gk[k0 + 2 * i + (lane >> 5)]; }
#pragma unroll
    for (int i = 0; i < 32; ++i) { const int kk = 2 * i + (lane >> 5); scr[kk * 33 + (lane & 31)] = wv[i] * scale; }
    LDS_WAIT(); asm volatile("" ::: "memory");
    const int c = lane & 7;
#pragma unroll
    for (int j = 0; j < 4; ++j) { const int n = (lane >> 3) + 8 * j; const LAS float* sp = scr + (8 * c) * 33 + n;
        v2u_ o; o.x = pg8::cvt4_fp8(sp[0 * 33], sp[1 * 33], sp[2 * 33], sp[3 * 33]); o.y = pg8::cvt4_fp8(sp[4 * 33], sp[5 * 33], sp[6 * 33], sp[7 * 33]);
        *(GAS v2u_*)(WT + (size_t)(row_off + n0 + n) * K + k0 + 8 * c) = o; }
    LDS_WAIT(); asm volatile("" ::: "memory");
}
__device__ __forceinline__ void rms_row_to_bf16(const float* xrow, const float* gain, bf16* orow, int lane) {
    const GAS f32x4* xr = (const GAS f32x4*)xrow + lane;
    f32x4 v[4]; float s = 0.f;
#pragma unroll
    for (int j = 0; j < 4; ++j) { v[j] = xr[64 * j]; s += (v[j].x * v[j].x + v[j].y * v[j].y) + (v[j].z * v[j].z + v[j].w * v[j].w); }
    const float r = 1.0f / sqrtf(wave_sum(s) * (1.f / 1024.f) + EPS);
    GAS unsigned long long* o8 = (GAS unsigned long long*)orow + lane;
#pragma unroll
    for (int j = 0; j < 4; ++j) { const f32x4 g = ((const GAS f32x4*)gain)[lane + 64 * j];
        o8[64 * j] = (unsigned long long)pk2(v[j].x * r * g.x, v[j].y * r * g.y) | ((unsigned long long)pk2(v[j].z * r * g.z, v[j].w * r * g.w) << 32); }
}

__device__ __forceinline__ void attn_phase(LAS unsigned char* lds, const bf16* Q, const bf16* KB, const bf16* VT, unsigned char* O, int G) {
    typedef short bf16x8 __attribute__((ext_vector_type(8)));
    typedef short bf16x4 __attribute__((ext_vector_type(4)));
    typedef float f32x16 __attribute__((ext_vector_type(16)));
    typedef unsigned v2u __attribute__((ext_vector_type(2)));
    const int tid = threadIdx.x, lane = tid & 63, wave = __builtin_amdgcn_readfirstlane(tid >> 6), r32 = lane & 31, hh = lane >> 5;
    constexpr int BUFB = 32768, OP = 272;
    unsigned koff[4], voff[4];
#pragma unroll
    for (int i4 = 0; i4 < 4; ++i4) { const int p_ = wave * 4 + i4;
        { const int r_ = 2 * p_ + (lane >> 5), cg_ = (lane & 31) ^ (r_ & 31); koff[i4] = (unsigned)(r_ * 1024 + cg_ * 8) * 2u; }
        { const int r_ = 8 * p_ + (lane >> 3), cg_ = (lane & 7) ^ ((r_ >> 1) & 7); voff[i4] = (unsigned)(r_ * 8192 + cg_ * 8) * 2u; } }
    for (int i = 0;; ++i) {
        pg8::StaticOrder so_; so_.init(T_, 1024, G, (int)blockIdx.x, WGM_N1K); pg8::Unit un_; if (!so_.next(i, un_)) break;
        const int qt = un_.pm & 7, h = un_.pn, b = un_.pm >> 3;
        const int t0 = b * S_ + qt * 256 + wave * 32;
        bf16x8 qf[16];
        { const bf16* qp = Q + (size_t)(t0 + r32) * 1024 + h * 256 + 8 * hh;
#pragma unroll
          for (int ks = 0; ks < 16; ++ks) qf[ks] = *(const bf16x8*)(qp + 16 * ks); }
        const bf16* kbase = KB + (size_t)(b * 256) * 1024 + h * 256;
        const bf16* vbase = VT + (size_t)(h * 256) * 8192 + b * 256;
#define AT_DMAK(c, buf) do { const char* kc_ = (const char*)kbase + (size_t)(c) * (64 * 1024 * 2); _Pragma("unroll") for (int i4 = 0; i4 < 4; ++i4) \
        __builtin_amdgcn_global_load_lds((const unsigned*)(kc_ + koff[i4]), (LAS unsigned*)(lds + (buf) * BUFB + (wave * 4 + i4) * 1024), 16, 0, 0); } while (0)
#define AT_DMAV(c, buf) do { const char* vc_ = (const char*)vbase + (size_t)(c) * (64 * 2); _Pragma("unroll") for (int i4 = 0; i4 < 4; ++i4) \
        __builtin_amdgcn_global_load_lds((const unsigned*)(vc_ + voff[i4]), (LAS unsigned*)(lds + (buf) * BUFB + (wave * 4 + i4) * 1024), 16, 0, 0); } while (0)
        f32x16 sacc[8];
#pragma unroll
        for (int k = 0; k < 8; ++k)
#pragma unroll
            for (int r = 0; r < 16; ++r) sacc[k][r] = 0.f;
        AT_DMAK(0, 0);
        const unsigned kx = (unsigned)(r32 * 512) ^ (unsigned)((hh ^ r32) << 4); unsigned kxv = kx;
#pragma unroll
        for (int c = 0; c < 4; ++c) {
            __syncthreads();
            if (c < 3) AT_DMAK(c + 1, (c + 1) & 1); else AT_DMAV(0, 0);
#pragma unroll
            for (int kt2 = 0; kt2 < 2; ++kt2) {
                const LAS unsigned char* kb = lds + (c & 1) * BUFB + kt2 * (32 * 512);
#pragma unroll
                for (int ks = 0; ks < 16; ++ks) { if ((ks & 3) == 0) asm volatile("" : "+v"(kxv));
                    const bf16x8 a = *(const LAS bf16x8*)(kb + (kxv ^ (unsigned)(32 * ks)));
                    sacc[2 * c + kt2] = __builtin_amdgcn_mfma_f32_32x32x16_bf16(a, qf[ks], sacc[2 * c + kt2], 0, 0, 0); }
            }
        }
        float m = sacc[0][0];
#pragma unroll
        for (int k = 0; k < 8; ++k)
#pragma unroll
            for (int r = 0; r < 16; ++r) m = fmaxf(m, sacc[k][r]);
        m = fmaxf(m, __shfl_xor(m, 32));
        const float sc = 0.0625f * 1.4426950408889634f; const float msc = m * sc; float sum = 0.f;
#pragma unroll
        for (int k = 0; k < 8; ++k)
#pragma unroll
            for (int r = 0; r < 16; ++r) { const float p = __builtin_amdgcn_exp2f(sacc[k][r] * sc - msc); sacc[k][r] = p; sum += p; }
        sum += __shfl_xor(sum, 32);
        const float inv = 1.0f / sum;
        bf16x8 pf[8][2];
#pragma unroll
        for (int k = 0; k < 8; ++k)
#pragma unroll
            for (int s2 = 0; s2 < 2; ++s2) { v4u w; w.x = pg8::cvt_pk_bf16(sacc[k][8 * s2 + 0], sacc[k][8 * s2 + 1]); w.y = pg8::cvt_pk_bf16(sacc[k][8 * s2 + 2], sacc[k][8 * s2 + 3]);
                w.z = pg8::cvt_pk_bf16(sacc[k][8 * s2 + 4], sacc[k][8 * s2 + 5]); w.w = pg8::cvt_pk_bf16(sacc[k][8 * s2 + 6], sacc[k][8 * s2 + 7]); pf[k][s2] = __builtin_bit_cast(bf16x8, w); }
        f32x16 oacc[8];
#pragma unroll
        for (int k = 0; k < 8; ++k)
#pragma unroll
            for (int r = 0; r < 16; ++r) oacc[k][r] = 0.f;
        const unsigned vx = (unsigned)(r32 * 128 + 8 * hh) ^ (unsigned)(((r32 >> 1) & 7) << 4); unsigned vxv = vx;
#pragma unroll
        for (int c = 0; c < 4; ++c) {
            __syncthreads();
            if (c < 3) AT_DMAV(c + 1, (c + 1) & 1);
#pragma unroll
            for (int dt = 0; dt < 8; ++dt) {
                const LAS unsigned char* vb = lds + (c & 1) * BUFB + dt * (32 * 128);
#pragma unroll
                for (int kk = 0; kk < 4; ++kk) { if ((kk & 1) == 0) asm volatile("" : "+v"(vxv));
                    const bf16x4 a0 = *(const LAS bf16x4*)(vb + (vxv ^ (unsigned)(32 * kk))), a1 = *(const LAS bf16x4*)(vb + (vxv ^ (unsigned)(32 * kk + 16)));
                    const bf16x8 a = __builtin_shufflevector(a0, a1, 0, 1, 2, 3, 4, 5, 6, 7);
                    oacc[dt] = __builtin_amdgcn_mfma_f32_32x32x16_bf16(a, pf[2 * c + (kk >> 1)][kk & 1], oacc[dt], 0, 0, 0); }
            }
        }
        __syncthreads();
        LAS unsigned char* ow = lds + wave * (32 * OP);
#pragma unroll
        for (int dt = 0; dt < 8; ++dt)
#pragma unroll
            for (int rg = 0; rg < 4; ++rg) { const f32x16& oa = oacc[dt];
                *(LAS unsigned*)(ow + r32 * OP + 32 * dt + 8 * rg + 4 * hh) = pg8::cvt4_fp8(oa[4 * rg] * inv, oa[4 * rg + 1] * inv, oa[4 * rg + 2] * inv, oa[4 * rg + 3] * inv); }
        LDS_WAIT(); asm volatile("" ::: "memory");
#pragma unroll
        for (int it = 0; it < 8; ++it) { const int idx = it * 64 + lane, row = idx >> 4, ch = idx & 15;
            const v4u w = *(const LAS v4u*)(ow + row * OP + ch * 16);
            *(v4u*)(O + (size_t)(t0 + row) * 1024 + h * 256 + ch * 16) = w; }
        LDS_WAIT(); asm volatile("" ::: "memory");
        __syncthreads();
#undef AT_DMAK
#undef AT_DMAV
    }
}

__device__ __forceinline__ f32x2v fast_gelu2(f32x2v x) {
    const f32x2v x2 = x * x, u = x * (x2 * 0.035677408136300125f + 0.7978845608028654f), t = u * (-2.885390081777927f);
    f32x2v e; e.x = __builtin_amdgcn_exp2f(t.x); e.y = __builtin_amdgcn_exp2f(t.y);
    const f32x2v d = e + 1.0f; f32x2v r; r.x = __builtin_amdgcn_rcpf(d.x); r.y = __builtin_amdgcn_rcpf(d.y);
    return x * r;
}
__device__ __forceinline__ float fast_gelu(float x) { const float u = x * (0.7978845608028654f + 0.035677408136300125f * x * x); return x * __builtin_amdgcn_rcpf(1.0f + __builtin_amdgcn_exp2f(-2.885390081777927f * u)); }
typedef short s16x4 __attribute__((ext_vector_type(4)));
__device__ __forceinline__ s16x4 lds_tr16(const LAS unsigned char* p) { return __builtin_bit_cast(s16x4, __builtin_amdgcn_ds_read_tr16_b64_v4i16((LAS s16x4*)p)); }
__device__ __forceinline__ void gmlp_unit(LAS unsigned char* lds, const bf16* PROJ, const bf16* WSP, const float* ln_gain, const float* bsp, const float* beta, bf16* Y, int unit) {
    typedef short bf16x8 __attribute__((ext_vector_type(8)));
    typedef float f32x16 __attribute__((ext_vector_type(16)));
    typedef unsigned v2u __attribute__((ext_vector_type(2)));
    const int tid = threadIdx.x, lane = tid & 63, wave = __builtin_amdgcn_readfirstlane(tid >> 6), r32 = lane & 31, hh = lane >> 5;
    constexpr int VP = 1088, UP = 1032, RED_OFF = 128 * UP;
    const size_t tok0 = (size_t)unit * 128;
    const int tt = wave >> 1, chf = wave & 1;
    bf16x8 wfc[8];
#pragma unroll
    for (int ks = 0; ks < 8; ++ks) wfc[ks] = *(const bf16x8*)(WSP + ((size_t)(32 * tt + r32)) * 128 + 16 * ks + 8 * hh);
    { v4u raw[16];
#pragma unroll
      for (int i = 0; i < 16; ++i) raw[i] = *(const v4u*)(PROJ + (tok0 + wave * 16 + i) * NPROJ + 512 + lane * 8);
      float gn[8];
#pragma unroll
      for (int j = 0; j < 8; ++j) gn[j] = ln_gain[lane * 8 + j];
#pragma unroll
      for (int i = 0; i < 16; ++i) { const int t = wave * 16 + i;
        const unsigned rw[4] = {raw[i].x, raw[i].y, raw[i].z, raw[i].w};
        float g[8]; float s = 0.f, q = 0.f;
#pragma unroll
        for (int j = 0; j < 4; ++j) { const f32x2v gg = fast_gelu2((f32x2v){__uint_as_float(rw[j] << 16), __uint_as_float(rw[j] & 0xffff0000u)}); g[2 * j] = gg.x; g[2 * j + 1] = gg.y; s += gg.x + gg.y; q += gg.x * gg.x + gg.y * gg.y; }
        s = wave_sum_dpp(s); q = wave_sum_dpp(q);
        const float mean = s * (1.f / 512.f), var = fmaxf(q * (1.f / 512.f) - mean * mean, 0.f);
        const float rstd = __builtin_amdgcn_rsqf(var + EPS);
        v4u o; o.x = pg8::cvt_pk_bf16((g[0] - mean) * rstd * gn[0], (g[1] - mean) * rstd * gn[1]); o.y = pg8::cvt_pk_bf16((g[2] - mean) * rstd * gn[2], (g[3] - mean) * rstd * gn[3]);
        o.z = pg8::cvt_pk_bf16((g[4] - mean) * rstd * gn[4], (g[5] - mean) * rstd * gn[5]); o.w = pg8::cvt_pk_bf16((g[6] - mean) * rstd * gn[6], (g[7] - mean) * rstd * gn[7]);
        *(LAS v4u*)(lds + t * VP + lane * 16) = o; } }
    __syncthreads();
    f32x16 acc[4][2];
#pragma unroll
    for (int g = 0; g < 4; ++g)
#pragma unroll
        for (int c2 = 0; c2 < 2; ++c2)
#pragma unroll
            for (int r = 0; r < 16; ++r) acc[g][c2][r] = 0.f;
    { const int q4 = (lane & 15) >> 2, p4 = lane & 3, blk = (lane >> 4) & 1;
      const LAS unsigned char* vtr0 = lds + (8 * hh + q4) * VP + (16 * blk + 4 * p4) * 2;
#pragma unroll
      for (int g = 0; g < 4; ++g) {
        bf16x8 wfn[8];
        if (g < 3) {
#pragma unroll
            for (int ks = 0; ks < 8; ++ks) wfn[ks] = *(const bf16x8*)(WSP + ((size_t)(g + 1) * 128 + 32 * tt + r32) * 128 + 16 * ks + 8 * hh); }
#pragma unroll
        for (int ks = 0; ks < 8; ++ks) if (ks < 2 * tt + 2) {
#pragma unroll
            for (int c2 = 0; c2 < 2; ++c2) { const LAS unsigned char* pa = vtr0 + ks * 16 * VP + (g * 128 + 32 * (2 * chf + c2)) * 2;
                const s16x4 a0 = lds_tr16(pa), a1 = lds_tr16(pa + 4 * VP);
                const bf16x8 a = __builtin_shufflevector(a0, a1, 0, 1, 2, 3, 4, 5, 6, 7);
                acc[g][c2] = __builtin_amdgcn_mfma_f32_32x32x16_bf16(a, wfc[ks], acc[g][c2], 0, 0, 0); } }
        if (g < 3) {
#pragma unroll
            for (int ks = 0; ks < 8; ++ks) wfc[ks] = wfn[ks]; }
      } }
    __syncthreads();
    v4u rawu[16];
#pragma unroll
    for (int i = 0; i < 16; ++i) rawu[i] = *(const v4u*)(PROJ + (tok0 + wave * 16 + i) * NPROJ + lane * 8);
    float biasv[4];
#pragma unroll
    for (int g = 0; g < 4; ++g) biasv[g] = bsp[g * 128 + 32 * tt + r32];
#pragma unroll
    for (int i = 0; i < 16; ++i) { const int t = wave * 16 + i;
        const unsigned rw[4] = {rawu[i].x, rawu[i].y, rawu[i].z, rawu[i].w};
        unsigned o[4];
#pragma unroll
        for (int j = 0; j < 4; ++j) { const f32x2v gg = fast_gelu2((f32x2v){__uint_as_float(rw[j] << 16), __uint_as_float(rw[j] & 0xffff0000u)}); o[j] = pg8::cvt_pk_bf16(gg.x, gg.y); }
        *(LAS v2u*)(lds + t * UP + lane * 16) = (v2u){o[0], o[1]}; *(LAS v2u*)(lds + t * UP + lane * 16 + 8) = (v2u){o[2], o[3]}; }
    __syncthreads();
    const int tl = 32 * tt + r32;
    float ssq = 0.f;
#pragma unroll
    for (int g = 0; g < 4; ++g) { const float bias = biasv[g];
#pragma unroll
        for (int c2 = 0; c2 < 2; ++c2)
#pragma unroll
            for (int rg = 0; rg < 4; ++rg) { const int ch = g * 128 + 32 * (2 * chf + c2) + 8 * rg + 4 * hh;
                const v2u uu = *(const LAS v2u*)(lds + tl * UP + ch * 2);
                const float u0 = __uint_as_float(uu.x << 16), u1 = __uint_as_float(uu.x & 0xffff0000u), u2 = __uint_as_float(uu.y << 16), u3 = __uint_as_float(uu.y & 0xffff0000u);
                float y0 = u0 * (acc[g][c2][4 * rg] + bias), y1 = u1 * (acc[g][c2][4 * rg + 1] + bias), y2 = u2 * (acc[g][c2][4 * rg + 2] + bias), y3 = u3 * (acc[g][c2][4 * rg + 3] + bias);
                acc[g][c2][4 * rg] = y0; acc[g][c2][4 * rg + 1] = y1; acc[g][c2][4 * rg + 2] = y2; acc[g][c2][4 * rg + 3] = y3;
                ssq += (y0 * y0 + y1 * y1) + (y2 * y2 + y3 * y3); } }
    ssq += __shfl_xor(ssq, 32);
    LAS float* red = (LAS float*)(lds + RED_OFF);
    if (hh == 0) red[tl * 2 + chf] = ssq;
    __syncthreads();
    const float rn = 1.0f / sqrtf((red[tl * 2] + red[tl * 2 + 1]) * (1.f / 512.f) + EPS);
#pragma unroll
    for (int g = 0; g < 4; ++g) {
        f32x4 btv[2][4];
#pragma unroll
        for (int c2 = 0; c2 < 2; ++c2)
#pragma unroll
            for (int rg = 0; rg < 4; ++rg) btv[c2][rg] = *(const f32x4*)(beta + g * 128 + 32 * (2 * chf + c2) + 8 * rg + 4 * hh);
        __builtin_amdgcn_sched_barrier(0);
#pragma unroll
        for (int c2 = 0; c2 < 2; ++c2)
#pragma unroll
            for (int rg = 0; rg < 4; ++rg) { const int ch = g * 128 + 32 * (2 * chf + c2) + 8 * rg + 4 * hh;
                const f32x4 bt = btv[c2][rg];
                v2u w; w.x = pg8::cvt_pk_bf16(acc[g][c2][4 * rg] * rn * bt.x, acc[g][c2][4 * rg + 1] * rn * bt.y); w.y = pg8::cvt_pk_bf16(acc[g][c2][4 * rg + 2] * rn * bt.z, acc[g][c2][4 * rg + 3] * rn * bt.w);
                *(LAS v2u*)(lds + tl * UP + ch * 2) = w; } }
    __syncthreads();
    { const LAS unsigned char* sp = lds + (tid >> 7) * UP + (tid & 127) * 8; bf16* gp = Y + (tok0 + (tid >> 7)) * 1024 + (tid & 127) * 4;
#pragma unroll 4
      for (int it = 0; it < 32; ++it) { *(v2u*)(gp + (size_t)it * 4 * 1024) = *(const LAS v2u*)(sp + it * 4 * UP); } }
    __syncthreads();
}

__device__ __forceinline__ void hgrn_seq(LAS unsigned char* lds, const bf16* PROJ, const float* lb_logits, const float* out_gain, bf16* Y, int seq, int nchunks) {
    typedef short bf16x8 __attribute__((ext_vector_type(8)));
    typedef float f32x16 __attribute__((ext_vector_type(16)));
    typedef unsigned v2u __attribute__((ext_vector_type(2)));
    const int tid = threadIdx.x, lane = tid & 63, wave = __builtin_amdgcn_readfirstlane(tid >> 6), r32 = lane & 31, hh = lane >> 5;
    const int b = seq >> 2, h = seq & 3;
    constexpr int QP = 272, TP = 320, GP = 264;
    constexpr int QD_O = 0, KI_O = 17408, KE_O = 34816, VV_O = 55296, GG_O = 75776, ST_O = 92672, SEG_O = 133632, DEC_O = 137728, SSQ_O = 138240;
#define HG_OFFB(row, ch) (256 * (row) + 16 * ((ch) ^ ((((row) & 3) << 2) | (((row) >> 2) & 3))))
    LAS float* SEG = (LAS float*)(lds + SEG_O); LAS float* DEC = (LAS float*)(lds + DEC_O); LAS float* SSQ = (LAS float*)(lds + SSQ_O);
    const float L2E = 1.4426950408889634f;
    float lb[2], og[2];
#pragma unroll
    for (int c = 0; c < 2; ++c) { const int ch = h * 128 + 2 * lane + c; const float l0 = lb_logits[ch], l1 = lb_logits[512 + ch], mx = fmaxf(l0, l1), e0 = __expf(l0 - mx), e1 = __expf(l1 - mx);
        lb[c] = e0 / (e0 + e1); og[c] = out_gain[ch]; }
    for (int i = tid; i < 128 * 256 / 4; i += 512) ((LAS unsigned*)(lds + ST_O))[i] = 0u;
    const int vt = wave & 3, it = wave >> 2;
    f32x16 stacc[2];
#pragma unroll
    for (int dd = 0; dd < 2; ++dd)
#pragma unroll
        for (int r = 0; r < 16; ++r) stacc[dd][r] = 0.f;
    const int q4 = (lane & 15) >> 2, p4 = lane & 3, blk = (lane >> 4) & 1;
    const int trc = (16 * blk + 4 * p4) * 2;
    unsigned rq[8], rf[8], rv[8], rg[8];
#define HG_LOAD(nn) do { const size_t tb_ = (size_t)b * S_ + (size_t)(nn) * 64; _Pragma("unroll") for (int k = 0; k < 8; ++k) { const bf16* row = PROJ + (tb_ + 8 * wave + k) * NPROJ + h * 128 + 2 * lane; \
        rq[k] = *(const unsigned*)(row + 1024); rf[k] = *(const unsigned*)(row + 1536); rv[k] = *(const unsigned*)(row + 2048); rg[k] = *(const unsigned*)(row + 2560); } } while (0)
    HG_LOAD(0);
    for (int n = 0; n < nchunks; ++n) {
        const size_t tb = (size_t)b * S_ + (size_t)n * 64;
        float kk0[8], kk1[8], cs0[8], cs1[8];
        { float run0 = 0.f, run1 = 0.f;
#pragma unroll
          for (int k = 0; k < 8; ++k) { const float x0 = __uint_as_float(rf[k] << 16), x1 = __uint_as_float(rf[k] & 0xffff0000u);
              const float s0 = __builtin_amdgcn_rcpf(1.0f + __builtin_amdgcn_exp2f(-L2E * x0)), s1 = __builtin_amdgcn_rcpf(1.0f + __builtin_amdgcn_exp2f(-L2E * x1));
              const float f0 = lb[0] + (1.0f - lb[0]) * s0, f1 = lb[1] + (1.0f - lb[1]) * s1;
              kk0[k] = 1.0f - f0; kk1[k] = 1.0f - f1; run0 += __builtin_amdgcn_logf(f0); run1 += __builtin_amdgcn_logf(f1); cs0[k] = run0; cs1[k] = run1; }
          *(LAS f32x2v*)(SEG + wave * 128 + 2 * lane) = (f32x2v){run0, run1}; }
        __syncthreads();
        { float off0 = 0.f, off1 = 0.f, tot0 = 0.f, tot1 = 0.f;
#pragma unroll
          for (int sgi = 0; sgi < 8; ++sgi) { const f32x2v sv = *(const LAS f32x2v*)(SEG + sgi * 128 + 2 * lane); tot0 += sv.x; tot1 += sv.y; if (sgi < wave) { off0 += sv.x; off1 += sv.y; } }
          const float et0 = __builtin_amdgcn_exp2f(tot0), et1 = __builtin_amdgcn_exp2f(tot1);
          if (wave == 0) *(LAS f32x2v*)(DEC + 2 * lane) = (f32x2v){et0, et1};
#pragma unroll
          for (int k = 0; k < 8; ++k) { const int t = 8 * wave + k;
              const float b0 = off0 + cs0[k], b1 = off1 + cs1[k];
              const float eb0 = __builtin_amdgcn_exp2f(b0), eb1 = __builtin_amdgcn_exp2f(b1), ib0 = __builtin_amdgcn_exp2f(-b0), ib1 = __builtin_amdgcn_exp2f(-b1);
              const float q0 = __uint_as_float(rq[k] << 16), q1 = __uint_as_float(rq[k] & 0xffff0000u), g0 = __uint_as_float(rg[k] << 16), g1 = __uint_as_float(rg[k] & 0xffff0000u);
              const float ki0 = kk0[k] * ib0, ki1 = kk1[k] * ib1;
              *(LAS unsigned*)(lds + QD_O + t * QP + 4 * lane) = pg8::cvt_pk_bf16(pg8::fast_silu(q0) * eb0, pg8::fast_silu(q1) * eb1);
              *(LAS unsigned*)(lds + KI_O + t * QP + 4 * lane) = pg8::cvt_pk_bf16(ki0, ki1);
              *(LAS unsigned*)(lds + KE_O + t * TP + 4 * lane) = pg8::cvt_pk_bf16(ki0 * et0, ki1 * et1);
              *(LAS unsigned*)(lds + VV_O + t * TP + 4 * lane) = rv[k];
              *(LAS unsigned*)(lds + GG_O + t * GP + 4 * lane) = pg8::cvt_pk_bf16(og[0] * pg8::fast_silu(g0), og[1] * pg8::fast_silu(g1)); } }
        __syncthreads();
        if (n + 1 < nchunks) HG_LOAD(n + 1);
        bf16x8 qf[8];
#pragma unroll
        for (int ks = 0; ks < 8; ++ks) qf[ks] = *(const LAS bf16x8*)(lds + QD_O + (32 * it + r32) * QP + (16 * ks + 8 * hh) * 2);
        f32x16 oacc;
#pragma unroll
        for (int r = 0; r < 16; ++r) oacc[r] = 0.f;
#pragma unroll
        for (int ks = 0; ks < 8; ++ks) { const int rw0 = 16 * ks + 8 * hh + q4, chh = 4 * vt + 2 * blk + (p4 >> 1);
            const s16x4 a0 = lds_tr16(lds + ST_O + HG_OFFB(rw0, chh) + 8 * (p4 & 1)), a1 = lds_tr16(lds + ST_O + HG_OFFB(rw0 + 4, chh) + 8 * (p4 & 1));
            oacc = __builtin_amdgcn_mfma_f32_32x32x16_bf16(__builtin_shufflevector(a0, a1, 0, 1, 2, 3, 4, 5, 6, 7), qf[ks], oacc, 0, 0, 0); }
#pragma unroll
        for (int jt = 0; jt < 2; ++jt) if (jt <= it) {
            f32x16 sx;
#pragma unroll
            for (int r = 0; r < 16; ++r) sx[r] = 0.f;
#pragma unroll
            for (int ks = 0; ks < 8; ++ks) { const bf16x8 a = *(const LAS bf16x8*)(lds + KI_O + (32 * jt + r32) * QP + (16 * ks + 8 * hh) * 2);
                sx = __builtin_amdgcn_mfma_f32_32x32x16_bf16(a, qf[ks], sx, 0, 0, 0); }
            if (jt == it) {
#pragma unroll
                for (int r = 0; r < 16; ++r) { const int jl = (r & 3) + 8 * (r >> 2) + 4 * hh; sx[r] = (jl <= r32) ? sx[r] : 0.f; } }
#pragma unroll
            for (int s2 = 0; s2 < 2; ++s2) {
                v4u w; w.x = pg8::cvt_pk_bf16(sx[8 * s2 + 0], sx[8 * s2 + 1]); w.y = pg8::cvt_pk_bf16(sx[8 * s2 + 2], sx[8 * s2 + 3]); w.z = pg8::cvt_pk_bf16(sx[8 * s2 + 4], sx[8 * s2 + 5]); w.w = pg8::cvt_pk_bf16(sx[8 * s2 + 6], sx[8 * s2 + 7]);
                const LAS unsigned char* pa = lds + VV_O + (32 * jt + 16 * s2 + 4 * hh + q4) * TP + 64 * vt + trc;
                const s16x4 a0 = lds_tr16(pa), a1 = lds_tr16(pa + 8 * TP);
                oacc = __builtin_amdgcn_mfma_f32_32x32x16_bf16(__builtin_shufflevector(a0, a1, 0, 1, 2, 3, 4, 5, 6, 7), __builtin_bit_cast(bf16x8, w), oacc, 0, 0, 0); }
        }
#pragma unroll
        for (int dd = 0; dd < 2; ++dd) { const int dt = 2 * it + dd; const float dec = DEC[32 * dt + r32];
#pragma unroll
            for (int r = 0; r < 16; ++r) stacc[dd][r] *= dec;
#pragma unroll
            for (int ks = 0; ks < 4; ++ks) { const LAS unsigned char* pa = lds + VV_O + (16 * ks + 8 * hh + q4) * TP + 64 * vt + trc; const LAS unsigned char* pb = lds + KE_O + (16 * ks + 8 * hh + q4) * TP + 64 * dt + trc;
                const s16x4 a0 = lds_tr16(pa), a1 = lds_tr16(pa + 4 * TP), b0 = lds_tr16(pb), b1 = lds_tr16(pb + 4 * TP);
                stacc[dd] = __builtin_amdgcn_mfma_f32_32x32x16_bf16(__builtin_shufflevector(a0, a1, 0, 1, 2, 3, 4, 5, 6, 7), __builtin_shufflevector(b0, b1, 0, 1, 2, 3, 4, 5, 6, 7), stacc[dd], 0, 0, 0); } }
        { float ssq = 0.f;
#pragma unroll
          for (int r = 0; r < 16; ++r) ssq += oacc[r] * oacc[r];
          ssq += __shfl_xor(ssq, 32);
          if (hh == 0) SSQ[(32 * it + r32) * 4 + vt] = ssq; }
        __syncthreads();
        { const int il = 32 * it + r32; const f32x4 sq = *(const LAS f32x4*)(SSQ + il * 4);
          const float rn = 1.0f / sqrtf(((sq.x + sq.y) + (sq.z + sq.w)) * (1.f / 128.f) + EPS);
#pragma unroll
          for (int rg4 = 0; rg4 < 4; ++rg4) { const int v0 = 32 * vt + 8 * rg4 + 4 * hh;
              const v2u gg = *(const LAS v2u*)(lds + GG_O + il * GP + v0 * 2);
              v2u w; w.x = pg8::cvt_pk_bf16(oacc[4 * rg4] * rn * __uint_as_float(gg.x << 16), oacc[4 * rg4 + 1] * rn * __uint_as_float(gg.x & 0xffff0000u));
              w.y = pg8::cvt_pk_bf16(oacc[4 * rg4 + 2] * rn * __uint_as_float(gg.y << 16), oacc[4 * rg4 + 3] * rn * __uint_as_float(gg.y & 0xffff0000u));
              *(LAS v2u*)(lds + QD_O + il * GP + v0 * 2) = w; }
#pragma unroll
          for (int dd = 0; dd < 2; ++dd) { const int d = 32 * (2 * it + dd) + r32;
#pragma unroll
              for (int rg4 = 0; rg4 < 4; ++rg4) { const int v0 = 32 * vt + 8 * rg4 + 4 * hh;
                  v2u w; w.x = pg8::cvt_pk_bf16(stacc[dd][4 * rg4], stacc[dd][4 * rg4 + 1]); w.y = pg8::cvt_pk_bf16(stacc[dd][4 * rg4 + 2], stacc[dd][4 * rg4 + 3]);
                  *(LAS v2u*)(lds + ST_O + HG_OFFB(d, 4 * vt + rg4) + 8 * hh) = w; } } }
        __syncthreads();
#pragma unroll
        for (int i4 = 0; i4 < 4; ++i4) { const int idx = i4 * 512 + tid, row = idx >> 5, pc = idx & 31;
            const v2u w = *(const LAS v2u*)(lds + QD_O + row * GP + pc * 8);
            *(v2u*)(Y + (tb + row) * 1024 + 512 + h * 128 + pc * 4) = w; }
    }
    __syncthreads();
#undef HG_LOAD
#undef HG_OFFB
}

__device__ __forceinline__ void rms_rows4_to_bf16(const float* xrow, const float* gain, bf16* orow, int lane, float* invr = nullptr, bool f8 = false) {
    f32x4 v[4][4]; float s[4]; f32x4 gq[4];
#pragma unroll
    for (int r = 0; r < 4; ++r)
#pragma unroll
        for (int j = 0; j < 4; ++j) v[r][j] = ((const GAS f32x4*)(xrow + (size_t)r * 1024))[lane + 64 * j];
#pragma unroll
    for (int j = 0; j < 4; ++j) gq[j] = ((const GAS f32x4*)gain)[lane + 64 * j];
#pragma unroll
    for (int r = 0; r < 4; ++r) { s[r] = 0.f;
#pragma unroll
        for (int j = 0; j < 4; ++j) s[r] += (v[r][j].x * v[r][j].x + v[r][j].y * v[r][j].y) + (v[r][j].z * v[r][j].z + v[r][j].w * v[r][j].w); }
#pragma unroll
    for (int r = 0; r < 4; ++r) s[r] = wave_sum_dpp(s[r]);
    if (invr && lane < 4) { const float sv = lane == 0 ? s[0] : (lane == 1 ? s[1] : (lane == 2 ? s[2] : s[3])); invr[lane] = sqrtf(sv * (1.f / 1024.f) + EPS); }
#pragma unroll
    for (int j = 0; j < 4; ++j) { const f32x4 g = gq[j];
#pragma unroll
        for (int r = 0; r < 4; ++r) { const float rr = __builtin_amdgcn_rsqf(s[r] * (1.f / 1024.f) + EPS);
            if (f8) { ((GAS unsigned*)((unsigned char*)orow + (size_t)r * 1024))[lane + 64 * j] = pg8::cvt4_fp8(v[r][j].x * rr * g.x, v[r][j].y * rr * g.y, v[r][j].z * rr * g.z, v[r][j].w * rr * g.w); continue; }
            ((GAS unsigned long long*)(orow + (size_t)r * 1024))[lane + 64 * j] = (unsigned long long)pg8::cvt_pk_bf16(v[r][j].x * rr * g.x, v[r][j].y * rr * g.y) | ((unsigned long long)pg8::cvt_pk_bf16(v[r][j].z * rr * g.z, v[r][j].w * rr * g.w) << 32); } }
}

__device__ __forceinline__ void hgrn_seq2(LAS unsigned char* lds, const bf16* PROJ, const float* lb_logits, const float* out_gain, bf16* Y, int seq, int nchunks) {
    typedef short bf16x8 __attribute__((ext_vector_type(8)));
    typedef float f32x16 __attribute__((ext_vector_type(16)));
    typedef unsigned v2u __attribute__((ext_vector_type(2)));
    const int tid = threadIdx.x, lane = tid & 63, wave = __builtin_amdgcn_readfirstlane(tid >> 6), r32 = lane & 31, hh = lane >> 5;
    const int b = seq >> 2, h = seq & 3;
    constexpr int QP = 272, TP = 320, GP = 264;
    constexpr int QD_O = 0, KI_O = 17408, VV_O = 33792, SETSZ = 54272, ST_O = 108544, OST_O = 141312, SEG_O = 158208, DEC_O = 160256, SSQ_O = 161280, OGL_O = 162304;
#define HG_OFFB(row, ch) (256 * (row) + 16 * ((ch) ^ ((((row) & 3) << 2) | (((row) >> 2) & 3))))
    LAS float* SEG = (LAS float*)(lds + SEG_O); LAS float* DEC = (LAS float*)(lds + DEC_O); LAS float* SSQ = (LAS float*)(lds + SSQ_O);
    const float L2E = 1.4426950408889634f;
    for (int i = tid; i < 128 * 256 / 4; i += 512) ((LAS unsigned*)(lds + ST_O))[i] = 0u;
    if (tid < 128) ((LAS float*)(lds + OGL_O))[tid] = out_gain[h * 128 + tid];
    if (wave < 4) {
        const int pw = wave;
        float lb[2];
#pragma unroll
        for (int c = 0; c < 2; ++c) { const int ch = h * 128 + 2 * lane + c; const float l0 = lb_logits[ch], l1 = lb_logits[512 + ch], mx = fmaxf(l0, l1), e0 = __expf(l0 - mx), e1 = __expf(l1 - mx); lb[c] = e0 / (e0 + e1); }
        const f32x2v lbv = {lb[0], lb[1]}, omlb = {1.0f - lb[0], 1.0f - lb[1]};
        unsigned rqA[16], rfA[16], rvA[16], rqB[16], rfB[16], rvB[16];
#define HG2_LOAD(nn, RQ, RF, RV) do { const size_t tb_ = (size_t)b * S_ + (size_t)(nn) * 64; _Pragma("unroll") for (int k = 0; k < 16; ++k) { const bf16* row = PROJ + (tb_ + 16 * pw + k) * NPROJ + h * 128 + 2 * lane; \
        RQ[k] = *(const unsigned*)(row + 1024); RF[k] = *(const unsigned*)(row + 1536); RV[k] = *(const unsigned*)(row + 2048); } } while (0)
#define HG2_PREP(nn, RQ, RF, RV) do { \
        f32x2v kk[16], cp[16];                                 \
        { f32x2v run = {1.f, 1.f}; \
          _Pragma("unroll") for (int k = 0; k < 16; ++k) { const f32x2v x = {__uint_as_float(RF[k] << 16), __uint_as_float(RF[k] & 0xffff0000u)}; const f32x2v t = x * (-L2E); \
              f32x2v e; e.x = __builtin_amdgcn_exp2f(t.x); e.y = __builtin_amdgcn_exp2f(t.y); const f32x2v d = e + 1.0f; f32x2v sg; sg.x = __builtin_amdgcn_rcpf(d.x); sg.y = __builtin_amdgcn_rcpf(d.y); \
              const f32x2v f = lbv + omlb * sg; kk[k] = 1.0f - f; run = run * f; cp[k] = run; } \
          *(LAS f32x2v*)(SEG + pw * 128 + 2 * lane) = run; } \
        __syncthreads();                                       \
        { f32x2v offp = {1.f, 1.f}, totp = {1.f, 1.f}; \
          _Pragma("unroll") for (int sgi = 0; sgi < 4; ++sgi) { const f32x2v sv = *(const LAS f32x2v*)(SEG + sgi * 128 + 2 * lane); totp = totp * sv; if (sgi < pw) offp = offp * sv; } \
          LAS unsigned char* set_ = lds + ((nn) & 1) * SETSZ; \
          if (pw == 0) *(LAS f32x2v*)(DEC + ((nn) & 1) * 128 + 2 * lane) = totp; \
          _Pragma("unroll") for (int k = 0; k < 16; ++k) { const int t = 16 * pw + k; \
              const f32x2v eb = offp * cp[k]; f32x2v ib; ib.x = __builtin_amdgcn_rcpf(eb.x); ib.y = __builtin_amdgcn_rcpf(eb.y); \
              const f32x2v q = {__uint_as_float(RQ[k] << 16), __uint_as_float(RQ[k] & 0xffff0000u)};     \
              const f32x2v qd = q * eb, ki = kk[k] * ib; \
              *(LAS unsigned*)(set_ + QD_O + t * QP + 4 * lane) = pg8::cvt_pk_bf16(qd.x, qd.y); \
              *(LAS unsigned*)(set_ + KI_O + HG_OFFB(t, lane >> 2) + 4 * (lane & 3)) = pg8::cvt_pk_bf16(ki.x, ki.y); \
              *(LAS unsigned*)(set_ + VV_O + t * TP + 4 * lane) = RV[k]; } } \
        if ((nn) + 2 < nchunks) HG2_LOAD((nn) + 2, RQ, RF, RV); \
        __syncthreads();                                       \
    } while (0)
        HG2_LOAD(0, rqA, rfA, rvA);
        if (nchunks > 1) HG2_LOAD(1, rqB, rfB, rvB);
        for (int n = 0; n < nchunks; n += 2) { HG2_PREP(n, rqA, rfA, rvA); HG2_PREP(n + 1, rqB, rfB, rvB); }
        __syncthreads(); __syncthreads();
#undef HG2_LOAD
#undef HG2_PREP
    } else {
        const int vt = wave - 4;
        const int q4 = (lane & 15) >> 2, p4 = lane & 3, blk = (lane >> 4) & 1;
        const int trc = (16 * blk + 4 * p4) * 2;
        const int c2 = 2 * blk + (p4 >> 1), f0 = (q4 << 2) | (2 * hh), f1 = (q4 << 2) | (2 * hh + 1);
        const int stb0 = ST_O + 256 * (8 * hh + q4) + 16 * ((4 * vt + c2) ^ f0) + 8 * (p4 & 1);
        const int stb1 = ST_O + 256 * (8 * hh + q4 + 4) + 16 * ((4 * vt + c2) ^ f1) + 8 * (p4 & 1);
        const int kt0 = 256 * (8 * hh + q4) + 16 * (c2 ^ f0) + 8 * (p4 & 1);
        const int kt1 = 256 * (8 * hh + q4 + 4) + 16 * (c2 ^ f1) + 8 * (p4 & 1);
        const int fr = ((r32 & 3) << 2) | ((r32 >> 2) & 3);
        const int kr = 256 * r32 + 16 * (hh ^ fr);
        const int swb = ST_O + 256 * r32 + 16 * ((4 * vt) ^ (fr & 12)) + 8 * hh, f3 = fr & 3;
        f32x16 stacc[4];
#pragma unroll
        for (int dt = 0; dt < 4; ++dt)
#pragma unroll
            for (int r = 0; r < 16; ++r) stacc[dt][r] = 0.f;
        const int t4 = tid - 256;
        const LAS unsigned char* ostr = lds + OST_O + (t4 >> 5) * GP + (t4 & 31) * 8;
        for (int n = 0; n <= nchunks; ++n) {
            const int c = n - 1;
            const size_t tb = (size_t)b * S_ + (size_t)(c < 0 ? 0 : c) * 64;
            f32x16 oacc[2]; v2u graw[2][4];
            if (c >= 1) {
                bf16* gp = Y + (tb - 64 + (t4 >> 5)) * 1024 + 512 + h * 128 + (t4 & 31) * 4;
#pragma unroll
                for (int i8 = 0; i8 < 8; ++i8) *(v2u*)(gp + (size_t)i8 * 8 * 1024) = *(const LAS v2u*)(ostr + i8 * 8 * GP); }
            if (c >= 0) {
                const int so = (c & 1) * SETSZ;
                const LAS unsigned char* set_ = lds + so;
                int krs = so + KI_O + kr, kts0 = so + KI_O + kt0, kts1 = so + KI_O + kt1;
                asm volatile("" : "+v"(krs), "+v"(kts0), "+v"(kts1));
#pragma unroll
                for (int it = 0; it < 2; ++it)
#pragma unroll
                    for (int rg4 = 0; rg4 < 4; ++rg4) graw[it][rg4] = *(const v2u*)(PROJ + (tb + 32 * it + r32) * NPROJ + 2560 + h * 128 + 32 * vt + 8 * rg4 + 4 * hh);
#pragma unroll
                for (int it = 0; it < 2; ++it) {
                    bf16x8 qf[8];
#pragma unroll
                    for (int ks = 0; ks < 8; ++ks) qf[ks] = *(const LAS bf16x8*)(set_ + QD_O + (32 * it + r32) * QP + (16 * ks + 8 * hh) * 2);
#pragma unroll
                    for (int r = 0; r < 16; ++r) oacc[it][r] = 0.f;
                    { bf16x8 af[8];
#pragma unroll
                      for (int ks = 0; ks < 8; ++ks) { const s16x4 a0 = lds_tr16(lds + stb0 + 4096 * ks), a1 = lds_tr16(lds + stb1 + 4096 * ks); af[ks] = __builtin_shufflevector(a0, a1, 0, 1, 2, 3, 4, 5, 6, 7); }
#pragma unroll
                      for (int ks = 0; ks < 8; ++ks) oacc[it] = __builtin_amdgcn_mfma_f32_32x32x16_bf16(af[ks], qf[ks], oacc[it], 0, 0, 0); }
#pragma unroll
                    for (int jt = 0; jt < 2; ++jt) if (jt <= it) {
                        bf16x8 kf[8], va[2];
#pragma unroll
                        for (int ks = 0; ks < 8; ++ks) kf[ks] = *(const LAS bf16x8*)(lds + 8192 * jt + (krs ^ (32 * ks)));
#pragma unroll
                        for (int s2 = 0; s2 < 2; ++s2) { const LAS unsigned char* pa = set_ + VV_O + (32 * jt + 16 * s2 + 4 * hh + q4) * TP + 64 * vt + trc;
                            const s16x4 a0 = lds_tr16(pa), a1 = lds_tr16(pa + 8 * TP); va[s2] = __builtin_shufflevector(a0, a1, 0, 1, 2, 3, 4, 5, 6, 7); }
                        f32x16 sx;
#pragma unroll
                        for (int r = 0; r < 16; ++r) sx[r] = 0.f;
#pragma unroll
                        for (int ks = 0; ks < 8; ++ks) sx = __builtin_amdgcn_mfma_f32_32x32x16_bf16(kf[ks], qf[ks], sx, 0, 0, 0);
                        { int lim = r32 + 32 * (it - jt); asm volatile("" : "+v"(lim));
#pragma unroll
                          for (int r = 0; r < 16; ++r) { const int jl = (r & 3) + 8 * (r >> 2) + 4 * hh; sx[r] = (jl <= lim) ? sx[r] : 0.f; } }
#pragma unroll
                        for (int s2 = 0; s2 < 2; ++s2) {
                            v4u w; w.x = pg8::cvt_pk_bf16(sx[8 * s2 + 0], sx[8 * s2 + 1]); w.y = pg8::cvt_pk_bf16(sx[8 * s2 + 2], sx[8 * s2 + 3]); w.z = pg8::cvt_pk_bf16(sx[8 * s2 + 4], sx[8 * s2 + 5]); w.w = pg8::cvt_pk_bf16(sx[8 * s2 + 6], sx[8 * s2 + 7]);
                            oacc[it] = __builtin_amdgcn_mfma_f32_32x32x16_bf16(va[s2], __builtin_bit_cast(bf16x8, w), oacc[it], 0, 0, 0); }
                    }
                    { float ssq = 0.f;
#pragma unroll
                      for (int r = 0; r < 16; ++r) ssq += oacc[it][r] * oacc[it][r];
                      ssq += __shfl_xor(ssq, 32);
                      if (hh == 0) SSQ[(32 * it + r32) * 4 + vt] = ssq; }
                }
                { bf16x8 vf[4];
#pragma unroll
                  for (int ks = 0; ks < 4; ++ks) { const LAS unsigned char* pa = set_ + VV_O + (16 * ks + 8 * hh + q4) * TP + 64 * vt + trc;
                      const s16x4 a0 = lds_tr16(pa), a1 = lds_tr16(pa + 4 * TP); vf[ks] = __builtin_shufflevector(a0, a1, 0, 1, 2, 3, 4, 5, 6, 7); }
#pragma unroll
                  for (int dt = 0; dt < 4; ++dt) { bf16x8 kb[4];
#pragma unroll
                      for (int ks = 0; ks < 4; ++ks) { const s16x4 b0 = lds_tr16(lds + 4096 * ks + (kts0 ^ (64 * dt))), b1 = lds_tr16(lds + 4096 * ks + (kts1 ^ (64 * dt))); kb[ks] = __builtin_shufflevector(b0, b1, 0, 1, 2, 3, 4, 5, 6, 7); }
#pragma unroll
                      for (int ks = 0; ks < 4; ++ks) stacc[dt] = __builtin_amdgcn_mfma_f32_32x32x16_bf16(vf[ks], kb[ks], stacc[dt], 0, 0, 0);
                      const float dec = DEC[(c & 1) * 128 + 32 * dt + r32];
#pragma unroll
                      for (int r = 0; r < 16; ++r) stacc[dt][r] *= dec; } }
            }
            __syncthreads();
            if (c >= 0) {
                f32x4 og4[4];
#pragma unroll
                for (int rg4 = 0; rg4 < 4; ++rg4) og4[rg4] = *(const LAS f32x4*)(lds + OGL_O + (32 * vt + 8 * rg4 + 4 * hh) * 4);
#pragma unroll
                for (int it = 0; it < 2; ++it) { const int il = 32 * it + r32; const f32x4 sq = *(const LAS f32x4*)(SSQ + il * 4);
                    const float rn = __builtin_amdgcn_rsqf(((sq.x + sq.y) + (sq.z + sq.w)) * (1.f / 128.f) + EPS);
#pragma unroll
                    for (int rg4 = 0; rg4 < 4; ++rg4) { const int v0 = 32 * vt + 8 * rg4 + 4 * hh; const v2u gg = graw[it][rg4];
                        const float g0 = og4[rg4].x * __uint_as_float(gg.x << 16), g1 = og4[rg4].y * __uint_as_float(gg.x & 0xffff0000u);
                        const float g2 = og4[rg4].z * __uint_as_float(gg.y << 16), g3 = og4[rg4].w * __uint_as_float(gg.y & 0xffff0000u);
                        v2u w; w.x = pg8::cvt_pk_bf16(oacc[it][4 * rg4] * rn * g0, oacc[it][4 * rg4 + 1] * rn * g1); w.y = pg8::cvt_pk_bf16(oacc[it][4 * rg4 + 2] * rn * g2, oacc[it][4 * rg4 + 3] * rn * g3);
                        *(LAS v2u*)(lds + OST_O + il * GP + v0 * 2) = w; } }
#pragma unroll
                for (int dt = 0; dt < 4; ++dt)
#pragma unroll
                    for (int rg4 = 0; rg4 < 4; ++rg4) { v2u w; w.x = pg8::cvt_pk_bf16(stacc[dt][4 * rg4], stacc[dt][4 * rg4 + 1]); w.y = pg8::cvt_pk_bf16(stacc[dt][4 * rg4 + 2], stacc[dt][4 * rg4 + 3]);
                        *(LAS v2u*)(lds + swb + 8192 * dt + 16 * (rg4 ^ f3)) = w; }
            }
            __syncthreads();
        }
        { bf16* gp = Y + ((size_t)b * S_ + (size_t)(nchunks - 1) * 64 + (t4 >> 5)) * 1024 + 512 + h * 128 + (t4 & 31) * 4;
#pragma unroll
          for (int i8 = 0; i8 < 8; ++i8) *(v2u*)(gp + (size_t)i8 * 8 * 1024) = *(const LAS v2u*)(ostr + i8 * 8 * GP); }
    }
    __syncthreads();
#undef HG_OFFB
}

struct Args { const float* in[25]; float* out; unsigned char* ws; int ph_lo, ph_hi, sub, pad; };

__global__ void __launch_bounds__(NWAVES * 64, 2) mk(Args args) {
    extern __shared__ __attribute__((aligned(16))) unsigned char lds_raw[];
    LAS unsigned char* lds = (LAS unsigned char*)lds_raw;
    volatile LAS unsigned* MISC = (volatile LAS unsigned*)(lds + MISC_OFF);
    const int tid = threadIdx.x, lane = tid & 63, wave = __builtin_amdgcn_readfirstlane(tid >> 6);
    const int G = gridDim.x;
    unsigned char* ws = args.ws;
    unsigned* ctl = (unsigned*)(ws + WS_CTL);
    for (int u = tid; u < (LDS_BYTES - LDSCTL_OFF) / 4; u += NWAVES * 64) ((LAS unsigned*)(lds + LDSCTL_OFF))[u] = 0u;
    __syncthreads();
    const int lo = args.ph_lo, hi = args.ph_hi;
    const bool multi = (hi - lo) > 1;
    XcdBarrier bar; bar.bar = ctl + CW_BAR; bar.x = 0; bar.st = nullptr;
    if (multi) bar = xcd_barrier_post(ctl + CW_BAR, MISC + 8);
#define IN(k) (lo <= (k) && (k) < hi)
#ifndef PROBE_K
#define PROBE_K (-1)
#endif
#ifndef PROBE_SUB
#define PROBE_SUB 3
#endif
#define SEAM(k) do { if (IN(k) && IN((k) + 1)) xcd_barrier(bar); } while (0)

    const float* x = args.in[0]; float* out = args.out;
    bf16* WIN = (bf16*)(ws + WS_WIN); bf16* WOUT = (bf16*)(ws + WS_WOUT); bf16* WXQ = (bf16*)(ws + WS_WXQ); bf16* WXKV = (bf16*)(ws + WS_WXKV); bf16* WXO = (bf16*)(ws + WS_WXO);
    bf16* WGU = (bf16*)(ws + WS_WGU); bf16* WDN = (bf16*)(ws + WS_WDN);
    bf16* A = (bf16*)(ws + WS_A); bf16* Y = (bf16*)(ws + WS_Y); bf16* MEMN = (bf16*)(ws + WS_MEMN); bf16* KV = (bf16*)(ws + WS_KV); bf16* PROJ = (bf16*)(ws + WS_PROJ);
    bf16* HID = (bf16*)(ws + WS_HID); bf16* YB = (bf16*)(ws + WS_YB); bf16* KBp = (bf16*)(ws + WS_KB); bf16* VTp = (bf16*)(ws + WS_VT);
    unsigned char* H1F8 = ws + WS_PROJ + 128 * MiB;
    unsigned char* O8 = ws + WS_PROJ;
    int* slot_tok = (int*)(ws + WS_SLOTTOK); float* slot_gate = (float*)(ws + WS_SLOTGATE); int* small = (int*)(ws + WS_SMALL);
    int* tok_e = (int*)(ws + WS_TOKE); float* tok_g = (float*)(ws + WS_TOKG); int* lpos = (int*)(ws + WS_LPOS); int* tok_slot = (int*)(ws + WS_TOKSLOT); int* hist = (int*)(ws + WS_HIST);
    float* invrs = (float*)(ws + WS_INVRS); float* invg = (float*)(ws + WS_INVRS + 256 * 1024);
    float* ssq1 = (float*)(ws + WS_PROJ + 256 * MiB);       float* rs = (float*)(ws + WS_RS); float* slot_rs = (float*)(ws + WS_SLOTRS); bf16* WRF = (bf16*)(ws + WS_WRF);
    const int gw = blockIdx.x * NWAVES + wave, NGW = G * NWAVES;

    if (IN(0)) {
        LAS float* scr = (LAS float*)(lds + RING_OFF + wave * 16384);
        constexpr int I_IN = 16 * 96, I_SQ = 16 * 32, I_KV = 16 * 64, I_E = 32 * 256;
        constexpr int NITEMS = I_IN + 3 * I_SQ + I_KV + (TAIL_GATE ? 0 : 1) * I_E;
        for (int it = gw; it < NITEMS; it += NGW) {
            int r = it;
            if (r < I_IN) { p0_transpose_item(args.in[3], 1024, 3072, WIN, 0, scr, r / 96, r % 96, lane); continue; } r -= I_IN;
            if (r < I_SQ) { p0_transpose_item(args.in[10], 1024, 1024, WOUT, 0, scr, r / 32, r % 32, lane); continue; } r -= I_SQ;
            if (r < I_SQ) { p0_transpose_item8(args.in[13], 1024, 1024, (unsigned char*)WXQ, 0, scr, r / 32, r % 32, lane, 64.0f, args.in[11]); continue; } r -= I_SQ;
            if (r < I_KV) { p0_transpose_item8(args.in[14], 1024, 2048, (unsigned char*)WXKV, 0, scr, r / 64, r % 64, lane, 64.0f); continue; } r -= I_KV;
            if (r < I_SQ) { p0_transpose_item8(args.in[15], 1024, 1024, (unsigned char*)WXO, 0, scr, r / 32, r % 32, lane, 64.0f); continue; } r -= I_SQ;
            {
                const int up = r >= I_E; if (up) r -= I_E;
                const int e = r >> 8, q = r & 255, kb = q >> 4, nb = q & 15, n0 = 32 * nb, dest = 256 * (n0 >> 7) + (n0 & 127) + (up ? 128 : 0);
                p0_transpose_item8(args.in[up ? 22 : 21] + (size_t)e * 1024 * 512, 1024, 512, (unsigned char*)WGU + (size_t)e * 1024 * 1024, dest - n0, scr, kb, nb, lane, 64.0f); }
        }
        for (int it = blockIdx.x * 512 + tid; it < 32 * 3 * 64; it += G * 512) {
            const int l = it & 63, nt = (it >> 6) % 3, ks = it / 192, n = 16 * nt + (l & 15), k0 = 32 * ks + 8 * (l >> 4);
            float w[8]; unsigned hi[4], lo[4];
#pragma unroll
            for (int j = 0; j < 8; ++j) w[j] = ((n < 4) ? args.in[17][(size_t)(k0 + j) * 4 + n] : (n < 36 ? args.in[19][(size_t)(k0 + j) * 32 + (n - 4)] : 0.f)) * args.in[16][k0 + j];
#pragma unroll
            for (int j = 0; j < 4; ++j) { const bf16 h0 = f2bf(w[2 * j]), h1 = f2bf(w[2 * j + 1]); hi[j] = (unsigned)h0 | ((unsigned)h1 << 16); lo[j] = pk2(w[2 * j] - bf2f(h0), w[2 * j + 1] - bf2f(h1)); }
            v4u* dst = (v4u*)(WRF + ((size_t)((ks * 3 + nt) * 2) * 64 + l) * 8);
            dst[0] = (v4u){hi[0], hi[1], hi[2], hi[3]}; dst[64] = (v4u){lo[0], lo[1], lo[2], lo[3]};
        }
        { bf16* WSPw = (bf16*)(ws + WS_WSP);
          for (int it = blockIdx.x * 512 + tid; it < 4 * 128 * 128; it += G * 512) { const int sI = it & 127, tI = (it >> 7) & 127; WSPw[it] = (sI <= tI) ? f2bf(args.in[5][it]) : (bf16)0; } }
        for (int m = gw * 4; m < T_; m += NGW * 4) rms_rows4_to_bf16(x + (size_t)m * 1024, args.in[2], A + (size_t)m * 1024, lane, invrs + m);
        for (int i = blockIdx.x * 512 + tid; i < 1024; i += G * 512) invg[i] = 1.0f / args.in[2][i];
        for (int m = gw * 4; m < MROWS; m += NGW * 4) rms_rows4_to_bf16(args.in[1] + (size_t)m * 1024, args.in[12], MEMN + (size_t)m * 512, lane, nullptr, true);
        __syncthreads();
    }
    SEAM(0);
    if (IN(1)) {
        { pg8::Gemm g{A, WIN, nullptr, T_, NPROJ, 1024}; pg8::StaticOrder S; S.init(T_, NPROJ, G, (int)blockIdx.x, WGM_P1);
          pg8::P1EPI E{PROJ, NPROJ, 1};
          pg8::gemm_phase<pg8::P1EPI, pg8::StaticOrder, true, false>(lds + RING_OFF, g, S, E); }
        { constexpr int tMem = (int)(WS_MEMN / (256 * 1024)), tW = (int)(WS_WXKV / (256 * 1024));
          pg8::Gemm g{(const bf16*)ws, (const bf16*)ws, nullptr, 0, 0, 1024}; pg8::KvOrder S{G, (int)blockIdx.x, tMem, tW};
          pg8::EpiKV E{KBp, VTp, tMem, tW};
          pg8::gemm_phase<pg8::EpiKV, pg8::KvOrder, true, false, true>(lds + RING_OFF, g, S, E); }
    }
    SEAM(1);
    if (IN(2)) {
        const int sub = args.sub;
        const bf16* WSPb = (const bf16*)(ws + WS_WSP);
        if (sub & 1) {
            const int first = (sub & 6) ? 128 : 0, nb = G - first;
            if ((int)blockIdx.x >= first) for (int u = (int)blockIdx.x - first; u < T_ / 128; u += ((sub & 8) ? 2 * nb : nb)) gmlp_unit(lds, PROJ, WSPb, args.in[4], args.in[6], args.in[7], Y, u);
        }
        if ((sub & 2) && ((int)blockIdx.x < 128 || (sub & 32))) hgrn_seq2(lds, PROJ, args.in[8], args.in[9], Y, (int)blockIdx.x & 127, (sub & 16) ? 16 : S_ / 64);
        if ((sub & 3) == 3 && !(sub & 0x3c)) {
            LAS float* scr = (LAS float*)(lds + RING_OFF + wave * 16384);
            constexpr int I_E = 32 * 256, TOT = (TAIL_GATE ? 3 : 2) * I_E, CUT = TOT * TAIL_HFRAC / 16;
            const bool isH = (int)blockIdx.x < 128;
            const int lo_ = isH ? 0 : CUT, hi_ = isH ? CUT : TOT, rank_ = isH ? (int)blockIdx.x : (int)blockIdx.x - 128;
            for (int it = lo_ + rank_ * NWAVES + wave; it < hi_; it += (isH ? 128 : G - 128) * NWAVES) {
                if (it >= 2 * I_E) { const int r = it - 2 * I_E, e = r >> 8, q = r & 255, kb = q >> 4, nbk = q & 15, n0 = 32 * nbk, dest = 256 * (n0 >> 7) + (n0 & 127);
                    p0_transpose_item8(args.in[21] + (size_t)e * 1024 * 512, 1024, 512, (unsigned char*)WGU + (size_t)e * 1024 * 1024, dest - n0, scr, kb, nbk, lane, 64.0f); }
                else if (it < I_E) { const int e = it >> 8, q = it & 255, kb = q >> 4, nbk = q & 15, n0 = 32 * nbk, dest = 256 * (n0 >> 7) + (n0 & 127) + 128;
                    p0_transpose_item8(args.in[22] + (size_t)e * 1024 * 512, 1024, 512, (unsigned char*)WGU + (size_t)e * 1024 * 1024, dest - n0, scr, kb, nbk, lane, 64.0f); }
                else { const int r = it - I_E, e = r >> 8, q = r & 255, kb = q >> 5, nbk = q & 31;
                    p0_transpose_item8(args.in[23] + (size_t)e * 512 * 1024, 512, 1024, (unsigned char*)WDN + (size_t)e * 1024 * 512, 0, scr, kb, nbk, lane, 32.0f); } }
        }
    }
    SEAM(2);
    if (IN(3)) {
        pg8::Gemm g{Y, WOUT, nullptr, T_, 1024, 1024}; pg8::StaticOrder S; S.init(T_, 1024, G, (int)blockIdx.x, WGM_N1K);
        pg8::P3EPI E{invrs, invg, A, ssq1, H1F8};
        pg8::gemm_phase<pg8::P3EPI, pg8::StaticOrder, true, false>(lds + RING_OFF, g, S, E);
    }
    SEAM(3);
    if (IN(5)) {
        pg8::Gemm g{(const bf16*)H1F8, WXQ, nullptr, T_, 1024, 1024}; pg8::StaticOrder S; S.init(T_, 1024, G, (int)blockIdx.x, WGM_N1K);
        pg8::P5EPI E{Y, ssq1, 1024, EPS, 1.0f / 64.0f, 0};
        pg8::gemm_phase<pg8::P5EPI, pg8::StaticOrder, true, false, true>(lds + RING_OFF, g, S, E);
    }
    if (IN(5) && IN(6)) { __syncthreads(); __builtin_amdgcn_fence(__ATOMIC_ACQUIRE, "agent"); __syncthreads(); }
    if (IN(6)) attn_phase(lds + RING_OFF, Y, KBp, VTp, O8, G);
    SEAM(6);
    if (IN(7)) {
        pg8::Gemm g{(const bf16*)O8, WXO, nullptr, T_, 1024, 1024}; pg8::StaticOrder S; S.init(T_, 1024, G, (int)blockIdx.x, WGM_N1K);
        pg8::P7EPI E{A, A, (unsigned char*)Y, args.in[16], ssq1, 1.0f / 64.0f, 0};
        pg8::gemm_phase<pg8::P7EPI, pg8::StaticOrder, true, false, true>(lds + RING_OFF, g, S, E);
    }
    SEAM(7);
    if (IN(8)) {
        typedef short bf16x8 __attribute__((ext_vector_type(8)));
        LAS float* lg = (LAS float*)(lds + wave * 6144);
        LAS int* hh = (LAS int*)(lds + 65536);
        const float* gain = args.in[16];
        for (int blk = blockIdx.x; blk < T_ / 256; blk += G) {
            if (tid < 32) hh[tid] = 0;
            __syncthreads();
            const int t0 = blk * 256 + wave * 32, fr = lane & 15, fq = lane >> 4;
            f32x4 acc[2][3];
#pragma unroll
            for (int mt = 0; mt < 2; ++mt)
#pragma unroll
                for (int nt = 0; nt < 3; ++nt) acc[mt][nt] = (f32x4){0.f, 0.f, 0.f, 0.f};
            const bf16* hrow = A + (size_t)(t0 + fr) * 1024 + 8 * fq;
            bf16x8 ra[4][2], rb[4][6];
#define P8_LD(st, ks_) do { _Pragma("unroll") for (int mt = 0; mt < 2; ++mt) ra[st][mt] = *(const bf16x8*)(hrow + (size_t)mt * 16 * 1024 + 32 * (ks_)); \
                _Pragma("unroll") for (int q = 0; q < 6; ++q) rb[st][q] = *(const bf16x8*)(WRF + ((size_t)((ks_) * 6 + q) * 64 + lane) * 8); } while (0)
            P8_LD(0, 0); P8_LD(1, 1); P8_LD(2, 2); P8_LD(3, 3);
#pragma unroll 1
            for (int k4 = 0; k4 < 32; k4 += 4) {
#pragma unroll
                for (int st = 0; st < 4; ++st) {
#pragma unroll
                    for (int nt = 0; nt < 3; ++nt)
#pragma unroll
                        for (int mt = 0; mt < 2; ++mt) {
                            acc[mt][nt] = __builtin_amdgcn_mfma_f32_16x16x32_bf16(ra[st][mt], rb[st][2 * nt], acc[mt][nt], 0, 0, 0);
                            acc[mt][nt] = __builtin_amdgcn_mfma_f32_16x16x32_bf16(ra[st][mt], rb[st][2 * nt + 1], acc[mt][nt], 0, 0, 0);
                        }
                    __builtin_amdgcn_sched_barrier(0);
                    if (k4 + 4 < 32) P8_LD(st, k4 + 4 + st);
                    __builtin_amdgcn_sched_barrier(0);
                }
            }
#undef P8_LD
            float rsv[2];
#pragma unroll
            for (int mt = 0; mt < 2; ++mt) { const f32x4* sp = (const f32x4*)(ssq1 + (size_t)(t0 + 16 * mt + fr) * 16); const f32x4 p0 = sp[0], p1 = sp[1], p2 = sp[2], p3 = sp[3];
                const float s = (((p0.x + p0.y) + (p0.z + p0.w)) + ((p1.x + p1.y) + (p1.z + p1.w))) + (((p2.x + p2.y) + (p2.z + p2.w)) + ((p3.x + p3.y) + (p3.z + p3.w))); rsv[mt] = 1.0f / sqrtf(s * (1.f / 1024.f) + EPS); }
#pragma unroll
            for (int mt = 0; mt < 2; ++mt)
#pragma unroll
                for (int nt = 0; nt < 3; ++nt)
#pragma unroll
                    for (int r = 0; r < 4; ++r) lg[(16 * mt + 4 * fq + r) * 48 + 16 * nt + fr] = acc[mt][nt][r];
            const float myrs = (lane & 16) ? rsv[1] : rsv[0];
            LDS_WAIT(); asm volatile("" ::: "memory");
            if (lane < 32) {
                const int t = t0 + lane; const LAS float* lr = lg + lane * 48;
                float gl[4], el[32];
#pragma unroll
                for (int o = 0; o < 4; ++o) gl[o] = lr[o] * myrs + args.in[18][o];
#pragma unroll
                for (int o = 0; o < 32; ++o) el[o] = lr[4 + o] * myrs + args.in[20][o];
                int gs = 0; float gm = gl[0];
#pragma unroll
                for (int o = 1; o < 4; ++o) if (gl[o] > gm) { gm = gl[o]; gs = o; }
                float gsum = 0.f;
#pragma unroll
                for (int o = 0; o < 4; ++o) gsum += expf(gl[o] - gm);
                const float ggate = 1.0f / gsum;
                float ev[8];
#pragma unroll
                for (int i = 0; i < 8; ++i) { float v = el[i];
#pragma unroll
                    for (int g2 = 1; g2 < 4; ++g2) v = (gs == g2) ? el[g2 * 8 + i] : v; ev[i] = v; }
                int i0 = 0; float v0 = ev[0];
#pragma unroll
                for (int i = 1; i < 8; ++i) if (ev[i] > v0) { v0 = ev[i]; i0 = i; }
                int i1 = -1; float v1 = -3.0e38f;
#pragma unroll
                for (int i = 0; i < 8; ++i) if (i != i0 && ev[i] > v1) { v1 = ev[i]; i1 = i; }
                if (i1 < 0) i1 = (i0 + 1) & 7;
                const float p0 = 1.0f / (1.0f + expf(v1 - v0)), p1 = 1.0f - p0;
                const int e0 = gs * 8 + i0, e1 = gs * 8 + i1;
                rs[t] = myrs; tok_e[t * 2] = e0; tok_e[t * 2 + 1] = e1; tok_g[t * 2] = p0 * ggate; tok_g[t * 2 + 1] = p1 * ggate;
                lpos[t * 2] = __hip_atomic_fetch_add((int*)(hh + e0), 1, __ATOMIC_RELAXED, __HIP_MEMORY_SCOPE_WORKGROUP); lpos[t * 2 + 1] = __hip_atomic_fetch_add((int*)(hh + e1), 1, __ATOMIC_RELAXED, __HIP_MEMORY_SCOPE_WORKGROUP);
            }
            __syncthreads();
            if (tid < 32) hist[blk * 32 + tid] = hh[tid];
            __syncthreads();
        }
        if (blockIdx.x == 0 && tid < 256) ((unsigned*)((unsigned char*)Y + (size_t)T_ * 1024))[tid] = 0u;
    }
    SEAM(8);
    if (IN(9)) {
        LAS int* sh = (LAS int*)lds;
        for (int blk = blockIdx.x; blk < T_ / 256; blk += G) {
            { const int e = tid & 31, p = tid >> 5; int s = 0, sp = 0;
              for (int b = 16 * p; b < 16 * p + 16; ++b) { const int h = hist[b * 32 + e]; s += h; sp += (b < blk) ? h : 0; }
              sh[128 + p * 32 + e] = s; sh[640 + p * 32 + e] = sp; }
            __syncthreads();
            if (tid < 32) { int s = 0, sp = 0; for (int p = 0; p < 16; ++p) { s += sh[128 + p * 32 + tid]; sp += sh[640 + p * 32 + tid]; } sh[tid] = s; sh[32 + tid] = sp; }
            __syncthreads();
            if (tid == 0) { int run = 0; for (int e = 0; e < 32; ++e) { sh[64 + e] = run; run += (sh[e] + EBLK - 1) / EBLK * EBLK; } sh[96] = run; }
            __syncthreads();
            { const int t = blk * 256 + (tid >> 1), k = tid & 1, e = tok_e[t * 2 + k]; const int slot = sh[64 + e] + sh[32 + e] + lpos[t * 2 + k];
              slot_tok[slot] = t; slot_gate[slot] = tok_g[t * 2 + k]; slot_rs[slot] = rs[t]; tok_slot[t * 2 + k] = slot; }
            if (blk < 32) for (int s = sh[64 + blk] + sh[blk] + tid; s < sh[64 + blk + 1]; s += 512) { slot_tok[s] = T_; slot_gate[s] = 0.f; slot_rs[s] = 0.f; }
            if (blk == 0) {
                if (tid < 33) small[SM_PADSTART + tid] = sh[64 + tid];
                for (int b = tid; b < NBLK; b += 512) { const int st = b * EBLK; int e = -1; for (int j = 0; j < 32; ++j) if (st >= sh[64 + j] && st < sh[64 + j + 1]) e = j; small[SM_BLOCKE + b] = e; }
            }
            __syncthreads();
        }
    }
    SEAM(9);
    if (IN(10)) {
        const int nblk_used = small[SM_PADSTART + 32] / EBLK;
        pg8::Gemm g{Y, WGU, slot_tok, 0, 0, 1024}; pg8::MoeOrder S; S.init(nblk_used, G, (int)blockIdx.x, small + SM_BLOCKE, WGM_MOE);
        pg8::EpiMoe1F8T E{(unsigned char*)HID, slot_rs};
        pg8::gemm_phase<pg8::EpiMoe1F8T, pg8::MoeOrder, true, true, true>(lds + RING_OFF, g, S, E);
    }
    SEAM(10);
    if (IN(11)) {
        const int nblk_used = small[SM_PADSTART + 32] / EBLK;
        pg8::Gemm g{HID, WDN, nullptr, 0, 0, 512}; pg8::MoeOrder S; S.init(nblk_used, G, (int)blockIdx.x, small + SM_BLOCKE, WGM_MOE);
        pg8::EpiMoe2T E{(unsigned char*)YB, slot_gate, 1.0f / 32.0f, 0};
        pg8::gemm_phase<pg8::EpiMoe2T, pg8::MoeOrder, true, false, true>(lds + RING_OFF, g, S, E);
    }
    SEAM(11);
    if (IN(12)) {
        const float* gain = args.in[24];
        f32x4 gfin[4];
#pragma unroll
        for (int j = 0; j < 4; ++j) gfin[j] = ((const GAS f32x4*)gain)[lane + 64 * j];
        for (int m0 = gw * 4; m0 < T_; m0 += NGW * 4) {
            f32x4 v[4][4]; unsigned ya[4][4], yc[4][4];
#pragma unroll
            for (int r = 0; r < 4; ++r) { const int m = m0 + r; const int s0 = tok_slot[m * 2], s1 = tok_slot[m * 2 + 1];
                const GAS unsigned long long* xr = (const GAS unsigned long long*)(A + (size_t)m * 1024) + lane;
                const GAS unsigned* y0 = (const GAS unsigned*)((const unsigned char*)YB + (size_t)s0 * 1024) + lane; const GAS unsigned* y1 = (const GAS unsigned*)((const unsigned char*)YB + (size_t)s1 * 1024) + lane;
#pragma unroll
                for (int j = 0; j < 4; ++j) { const unsigned long long hb = xr[64 * j]; v[r][j] = (f32x4){__uint_as_float((unsigned)hb << 16), __uint_as_float((unsigned)hb & 0xffff0000u), __uint_as_float((unsigned)(hb >> 32) << 16), __uint_as_float((unsigned)(hb >> 32) & 0xffff0000u)}; ya[r][j] = y0[64 * j]; yc[r][j] = y1[64 * j]; } }
#pragma unroll
            for (int r = 0; r < 4; ++r) { float s = 0.f;
#pragma unroll
                for (int j = 0; j < 4; ++j) { const unsigned a = ya[r][j], c = yc[r][j];
                    v[r][j].x += (__builtin_amdgcn_cvt_f32_fp8((int)a, 0) + __builtin_amdgcn_cvt_f32_fp8((int)c, 0)) * 0.0625f; v[r][j].y += (__builtin_amdgcn_cvt_f32_fp8((int)a, 1) + __builtin_amdgcn_cvt_f32_fp8((int)c, 1)) * 0.0625f;
                    v[r][j].z += (__builtin_amdgcn_cvt_f32_fp8((int)a, 2) + __builtin_amdgcn_cvt_f32_fp8((int)c, 2)) * 0.0625f; v[r][j].w += (__builtin_amdgcn_cvt_f32_fp8((int)a, 3) + __builtin_amdgcn_cvt_f32_fp8((int)c, 3)) * 0.0625f;
                    s += (v[r][j].x * v[r][j].x + v[r][j].y * v[r][j].y) + (v[r][j].z * v[r][j].z + v[r][j].w * v[r][j].w); }
                const float rr = 1.0f / sqrtf(wave_sum_dpp(s) * (1.f / 1024.f) + EPS);
                GAS f32x4* xw = (GAS f32x4*)(out + (size_t)(m0 + r) * 1024) + lane;
#pragma unroll
                for (int j = 0; j < 4; ++j) { const f32x4 g = gfin[j]; xw[64 * j] = (f32x4){v[r][j].x * rr * g.x, v[r][j].y * rr * g.y, v[r][j].z * rr * g.z, v[r][j].w * rr * g.w}; } }
        }
    }
#undef IN
#undef SEAM
}
#ifndef FAST_MASK
#define FAST_MASK 0xFFFF
#endif
extern "C" void kernel_launch(void* const* d_in, const int* in_sizes, int n_in, void* d_out, int out_size, void* d_ws, size_t ws_size, hipStream_t stream) {
    if (n_in != 25 || out_size != T_ * D_ || ws_size < WS_END) { fprintf(stderr, "kernel_launch: unexpected shapes n_in %d out %d ws %zu\n", n_in, out_size, ws_size); return; }
    static int grid = 0;
    if (grid == 0) {
        int dev = 0, cus = 0;
        if (hipGetDevice(&dev) != hipSuccess || hipDeviceGetAttribute(&cus, hipDeviceAttributeMultiprocessorCount, dev) != hipSuccess) { grid = -1; return; }
        if (hipFuncSetAttribute((const void*)mk, hipFuncAttributeMaxDynamicSharedMemorySize, LDS_BYTES) != hipSuccess) { fprintf(stderr, "hipFuncSetAttribute failed\n"); grid = -1; return; }
        int per_cu = 0; (void)hipOccupancyMaxActiveBlocksPerMultiprocessor(&per_cu, (const void*)mk, NWAVES * 64, LDS_BYTES); (void)hipGetLastError();
        if (cus < 64) { fprintf(stderr, "kernel_launch: needs at least 64 CUs\n"); grid = -1; return; }
        grid = cus;
    }
    if (grid < 0) return;
    const float* x = (const float*)d_in[0]; const float* mem = (const float*)d_in[1]; const float* norm_mix = (const float*)d_in[2]; const float* w_in = (const float*)d_in[3];
    const float* gmlp_ln = (const float*)d_in[4]; const float* gmlp_w = (const float*)d_in[5]; const float* gmlp_b = (const float*)d_in[6]; const float* gmlp_beta = (const float*)d_in[7];
    const float* lb_logits = (const float*)d_in[8]; const float* out_gain = (const float*)d_in[9]; const float* w_out = (const float*)d_in[10]; const float* norm_xattn = (const float*)d_in[11];
    const float* norm_mem = (const float*)d_in[12]; const float* w_xq = (const float*)d_in[13]; const float* w_xkv = (const float*)d_in[14]; const float* w_xo = (const float*)d_in[15];
    const float* norm_ffn = (const float*)d_in[16]; const float* wrg = (const float*)d_in[17]; const float* brg = (const float*)d_in[18]; const float* wre = (const float*)d_in[19]; const float* bre = (const float*)d_in[20];
    const float* weg = (const float*)d_in[21]; const float* weu = (const float*)d_in[22]; const float* wed = (const float*)d_in[23]; const float* norm_final = (const float*)d_in[24];
    unsigned char* ws = (unsigned char*)d_ws; float* out = (float*)d_out;
    bf16* A = (bf16*)(ws + WS_A); bf16* Y = (bf16*)(ws + WS_Y); bf16* MEMN = (bf16*)(ws + WS_MEMN); bf16* KV = (bf16*)(ws + WS_KVOLD); bf16* PROJ = (bf16*)(ws + WS_PROJ);
    bf16* HID = (bf16*)(ws + WS_HID); bf16* YB = (bf16*)(ws + WS_YB);
    int* tok_e = (int*)(ws + WS_TOKE); float* tok_g = (float*)(ws + WS_TOKG); int* lpos = (int*)(ws + WS_LPOS); int* tok_slot = (int*)(ws + WS_TOKSLOT);
    int* slot_tok = (int*)(ws + WS_SLOTTOK); float* slot_gate = (float*)(ws + WS_SLOTGATE); int* hist = (int*)(ws + WS_HIST); int* base = (int*)(ws + WS_BASE); int* small = (int*)(ws + WS_SMALL); float* rs = (float*)(ws + WS_RS); float* slot_rs = (float*)(ws + WS_SLOTRS);
    float* scr0 = out; float* scr1 = out + (size_t)T_ * 512;

    (void)hipMemsetAsync(ws + WS_CTL, 0, CTL_ZERO_BYTES, stream);
    Args a{};
    for (int i = 0; i < 25; ++i) a.in[i] = (const float*)d_in[i];
    a.out = out; a.ws = ws;
#define FAST(k) ((FAST_MASK >> (k)) & 1)
#ifndef PROBE_K
#define PROBE_K (-1)
#endif
#ifndef PROBE_N
#define PROBE_N 4
#endif
#ifndef PROBE_SUB
#define PROBE_SUB 3
#endif
#define PROBE(k) do { if (PROBE_K == (k)) { if ((k) == 2) a.sub = PROBE_SUB; for (int r_ = 0; r_ < PROBE_N; ++r_) RUN_FAST((k), (k) + 1); } } while (0)
#define RUN_FAST(lo_, hi_) do { a.ph_lo = (lo_); a.ph_hi = (hi_); hipLaunchKernelGGL(mk, dim3(grid), dim3(NWAVES * 64), LDS_BYTES, stream, a); } while (0)
#ifdef PROBE_SPLIT
    { a.sub = 3; RUN_FAST(0, PROBE_SPLIT); RUN_FAST(PROBE_SPLIT, PROBE_SPLIT + 1); a.sub = PROBE_SUB; for (int r_ = 0; r_ < PROBE_N; ++r_) RUN_FAST(PROBE_SPLIT, PROBE_SPLIT + 1); a.sub = 3;
      (void)hipMemsetAsync(ws + WS_CTL, 0, CTL_ZERO_BYTES, stream); RUN_FAST(PROBE_SPLIT + 1, 13); return; }
#endif
    if (FAST_MASK == 0xFFFF) { a.sub = 3; RUN_FAST(0, 13); return; }
    if (FAST(0)) { RUN_FAST(0, 1); PROBE(0); }
    else { k_rmsnorm1024<<<T_ / 4, 256, 0, stream>>>(x, norm_mix, A, T_, 0); k_rmsnorm1024<<<MROWS / 4, 256, 0, stream>>>(mem, norm_mem, MEMN, MROWS, 0); }
    if (FAST(1)) { RUN_FAST(1, 2); PROBE(1); }
    else { k_gemm_naive<ALPlain, BLPlain, EPBf16, false><<<dim3(NPROJ / 64, T_ / 64), 256, 0, stream>>>(ALPlain{A, 1024, 0}, BLPlain{w_in, NPROJ, 0}, EPBf16{PROJ, NPROJ, 0}, nullptr, nullptr, 1024, 0);
         }
    if (!FAST(6)) k_gemm_naive<ALPlain, BLPlain, EPBf16, false><<<dim3(2048 / 64, MROWS / 64), 256, 0, stream>>>(ALPlain{MEMN, 1024, 0}, BLPlain{w_xkv, 2048, 0}, EPBf16{KV, 2048, 0}, nullptr, nullptr, 1024, 0);
    a.sub = (FAST(2) ? 3 : 0) | FAST(13) | (FAST(14) << 1);
    if (a.sub) { RUN_FAST(2, 3); PROBE(2); }
    if (!(a.sub & 1)) { k_gmlp_ln<<<T_ / 4, 256, 0, stream>>>(PROJ, gmlp_ln, scr0);
           k_gmlp_spatial<<<(unsigned)((size_t)T_ * 512 / 256), 256, 0, stream>>>(PROJ, scr0, gmlp_w, gmlp_b, scr1);
           k_rmsnorm512<<<T_ / 4, 256, 0, stream>>>(scr1, gmlp_beta, Y); }
    if (!(a.sub & 2)) { k_hgrn_rec<<<B_ * 4, 128, 0, stream>>>(PROJ, lb_logits, scr0);
           k_hgrn_out<<<T_ / 4, 256, 0, stream>>>(scr0, PROJ, out_gain, Y); }
    if (FAST(3)) { RUN_FAST(3, 4); PROBE(3); }
    else k_gemm_naive<ALPlain, BLPlain, EPRes, false><<<dim3(1024 / 64, T_ / 64), 256, 0, stream>>>(ALPlain{Y, 1024, 0}, BLPlain{w_out, 1024, 0}, EPRes{x, out, 1024, 0}, nullptr, nullptr, 1024, 0);
    if (!FAST(4)) k_rmsnorm1024<<<T_ / 4, 256, 0, stream>>>(out, norm_xattn, A, T_, 0);
    if (FAST(5)) { RUN_FAST(5, 6); PROBE(5); }
    else k_gemm_naive<ALPlain, BLPlain, EPBf16, false><<<dim3(1024 / 64, T_ / 64), 256, 0, stream>>>(ALPlain{A, 1024, 0}, BLPlain{w_xq, 1024, 0}, EPBf16{Y, 1024, 0}, nullptr, nullptr, 1024, 0);
    if (FAST(6)) { RUN_FAST(6, 7); PROBE(6); }
    else k_attn_naive<<<T_, 256, 0, stream>>>(Y, KV, A);
    if (FAST(7)) RUN_FAST(7, 8);
    else k_gemm_naive<ALPlain, BLPlain, EPRes, false><<<dim3(1024 / 64, T_ / 64), 256, 0, stream>>>(ALPlain{A, 1024, 0}, BLPlain{w_xo, 1024, 0}, EPRes{out, out, 1024, 0}, nullptr, nullptr, 1024, 0);
    if (FAST(8)) { RUN_FAST(8, 9); PROBE(8); }
    else { k_router_naive<<<T_ / 4, 256, 0, stream>>>(out, norm_ffn, wrg, brg, wre, bre, Y, tok_e, tok_g, rs);
           (void)hipMemsetAsync(Y + (size_t)T_ * 1024, 0, 2048, stream);
           k_route_hist<<<256, 256, 0, stream>>>(tok_e, lpos, hist); }
    if (FAST(9)) { RUN_FAST(9, 10); PROBE(9); }
    else { k_route_scan<<<1, 256, 0, stream>>>(hist, base, small);
           k_route_fill<<<256, 256, 0, stream>>>(tok_e, tok_g, lpos, base, small, slot_tok, slot_gate, tok_slot, rs, slot_rs); }
    if (FAST(10)) { RUN_FAST(10, 11); PROBE(10); }
    else k_gemm_naive<ALGather, BLMoe1, EPBf16, true><<<dim3(512 / 32, NSLOT / 64), 256, 0, stream>>>(ALGather{Y, slot_tok, 1024, 0}, BLMoe1{weg, weu, small + SM_BLOCKE}, EPBf16{nullptr, 0, 0}, HID, slot_rs, 1024, 0);
    if (FAST(11)) { RUN_FAST(11, 12); PROBE(11); }
    else k_gemm_naive<ALPlain, BLMoe2, EPScale, false><<<dim3(1024 / 64, NSLOT / 64), 256, 0, stream>>>(ALPlain{HID, 512, 0}, BLMoe2{wed, small + SM_BLOCKE}, EPScale{YB, slot_gate, 1024, 0}, nullptr, nullptr, 512, 0);
    if (FAST(12)) RUN_FAST(12, 13);
    else k_final<<<T_ / 4, 256, 0, stream>>>(out, YB, tok_slot, norm_final);
}
```
